# Optimizing an MI355X kernel written in HIP

```python
import jax, jax.numpy as jnp
from jax import lax
import numpy as np

D_MODEL = 1024
BATCH = 8
SEQ = 8192
DEPTH = 1
DEC_BATCH = 32
DEC_SEQ = 16
PAST_LEN = 1024

CHUNK = 64
D_A = 1024
D_B = 512
D_MIX = D_A + D_B
N_HEADS_A = 16
HEAD_DIM_A = D_A // N_HEADS_A
CONV_A = 4
CONV_B = 3
LRU_C = 8.0
EPS = 1e-6
D_PROJ = 2 * D_A + 4 * D_B
SPLITS = (D_A, 2 * D_A, 2 * D_A + D_B, 2 * D_A + 2 * D_B, 2 * D_A + 3 * D_B)

kernel_name = "hymba_rglru_shortconv_stream_step"


def _rmsnorm_f32(x, g):
    xf = x.astype(jnp.float32)
    r = lax.rsqrt(jnp.mean(xf * xf, axis=-1, keepdims=True) + EPS)
    return xf * r * g.astype(jnp.float32)


def _causal_dwconv(x, hist, w):
    W = w.shape[0]
    T = x.shape[1]
    xe = jnp.concatenate([hist.astype(x.dtype), x], axis=1)
    y = w[0] * xe[:, 0:T]
    for k in range(1, W):
        y = y + w[k] * xe[:, k:k + T]
    return y, xe[:, xe.shape[1] - (W - 1):]


def _lru_combine(left, right):
    a1, b1 = left
    a2, b2 = right
    return a1 * a2, a2 * b1 + b2


def _rg_lru(x, h0, w_rg, b_rg, w_ig, b_ig, lam):
    Bn, T, _ = x.shape
    xf = x.astype(jnp.float32)
    xh = xf.reshape(Bn, T, N_HEADS_A, HEAD_DIM_A)
    r = jax.nn.sigmoid(jnp.einsum('bthi,hij->bthj', xh, w_rg.astype(jnp.float32)).reshape(Bn, T, D_A) + b_rg)
    i = jax.nn.sigmoid(jnp.einsum('bthi,hij->bthj', xh, w_ig.astype(jnp.float32)).reshape(Bn, T, D_A) + b_ig)
    log_a = -LRU_C * r * jax.nn.softplus(-lam.astype(jnp.float32))
    a = jnp.exp(log_a)
    b = jnp.sqrt(-jnp.expm1(2.0 * log_a)) * (i * xf)
    b = b.at[:, 0].add(a[:, 0] * h0.astype(jnp.float32))
    _, h = lax.associative_scan(_lru_combine, (a, b), axis=1)
    return h, h[:, -1]


def _layer(x, c, conv_a_hist, h0, conv_b_hist,
           g_norm, w_ada, b_ada, w_in, w_conv_a, b_conv_a,
           w_rg, b_rg, w_ig, b_ig, lam, w_conv_b, w_out):
    dt = x.dtype
    ada = jax.nn.silu(c.astype(jnp.float32)) @ w_ada.astype(jnp.float32) + b_ada
    shift, scale, gate = jnp.split(ada, 3, axis=-1)
    hn = _rmsnorm_f32(x, g_norm) * (1.0 + scale[:, None]) + shift[:, None]
    proj = jnp.einsum('btd,dp->btp', hn.astype(dt), w_in)
    x_a, g_a, x_b, bgate, cgate, g_b = jnp.split(proj, SPLITS, axis=-1)
    xa_c, new_conv_a = _causal_dwconv(x_a, conv_a_hist, w_conv_a)
    h, h_last = _rg_lru(xa_c + b_conv_a, h0, w_rg, b_rg, w_ig, b_ig, lam)
    y_a = h.astype(dt) * jax.nn.silu(g_a)
    u, new_conv_b = _causal_dwconv(cgate * x_b, conv_b_hist, w_conv_b)
    y_b = bgate * u * jax.nn.silu(g_b)
    out = jnp.einsum('btm,md->btd', jnp.concatenate([y_a, y_b], axis=-1), w_out)
    x = (x.astype(jnp.float32) + gate[:, None] * out.astype(jnp.float32)).astype(dt)
    return x, new_conv_a, h_last.astype(h0.dtype), new_conv_b


def setup_inputs(seed: int = 0) -> dict:
    key = jax.random.key(seed)
    ks = jax.random.split(key, 24)
    f32 = jnp.float32
    nrm = lambda k, s, sc: jax.random.normal(k, s, f32) * sc
    a0 = jax.random.uniform(ks[15], (DEPTH, D_A), f32, 0.9, 0.999)
    return {
        "x_prompt": nrm(ks[0], (BATCH, SEQ, D_MODEL), 1.0),
        "x_sample": nrm(ks[1], (DEC_BATCH, DEC_SEQ, D_MODEL), 1.0),
        "c_prompt": nrm(ks[2], (BATCH, D_MODEL), 1.0),
        "c_sample": nrm(ks[3], (DEC_BATCH, D_MODEL), 1.0),
        "cache_conv_a": nrm(ks[4], (DEPTH, DEC_BATCH, CONV_A - 1, D_A), 1.0),
        "state_lru": nrm(ks[5], (DEPTH, DEC_BATCH, D_A), 0.5),
        "cache_conv_b": nrm(ks[6], (DEPTH, DEC_BATCH, CONV_B - 1, D_B), 1.0),
        "g_norm": 1.0 + nrm(ks[7], (DEPTH, D_MODEL), 0.01),
        "w_ada": nrm(ks[8], (DEPTH, D_MODEL, 3 * D_MODEL), 0.5 * D_MODEL ** -0.5),
        "b_ada": nrm(ks[9], (DEPTH, 3 * D_MODEL), 0.01),
        "w_in": nrm(ks[10], (DEPTH, D_MODEL, D_PROJ), D_MODEL ** -0.5),
        "w_conv_a": nrm(ks[11], (DEPTH, CONV_A, D_A), CONV_A ** -0.5),
        "b_conv_a": nrm(ks[12], (DEPTH, D_A), 0.01),
        "w_rg": nrm(ks[13], (DEPTH, N_HEADS_A, HEAD_DIM_A, HEAD_DIM_A), HEAD_DIM_A ** -0.5),
        "b_rg": nrm(ks[14], (DEPTH, D_A), 0.01),
        "w_ig": nrm(ks[16], (DEPTH, N_HEADS_A, HEAD_DIM_A, HEAD_DIM_A), HEAD_DIM_A ** -0.5),
        "b_ig": nrm(ks[17], (DEPTH, D_A), 0.01),
        "lam": jnp.log(a0) - jnp.log1p(-a0),
        "w_conv_b": nrm(ks[18], (DEPTH, CONV_B, D_B), CONV_B ** -0.5),
        "w_out": nrm(ks[19], (DEPTH, D_MIX, D_MODEL), D_MIX ** -0.5),
        "g_final": 1.0 + nrm(ks[20], (D_MODEL,), 0.01),
    }


def reference(x_prompt, x_sample, c_prompt, c_sample, cache_conv_a, state_lru, cache_conv_b,
              g_norm, w_ada, b_ada, w_in, w_conv_a, b_conv_a, w_rg, b_rg, w_ig, b_ig, lam,
              w_conv_b, w_out, g_final):
    xp, xs = x_prompt, x_sample
    ca_p, h_p, cb_p, ca_s, h_s, cb_s = [], [], [], [], [], []
    Bp = x_prompt.shape[0]
    dt = x_prompt.dtype
    for l in range(DEPTH):
        params = (g_norm[l], w_ada[l], b_ada[l], w_in[l], w_conv_a[l], b_conv_a[l],
                  w_rg[l], b_rg[l], w_ig[l], b_ig[l], lam[l], w_conv_b[l], w_out[l])
        xp, a1, h1, b1 = _layer(xp, c_prompt,
                                jnp.zeros((Bp, CONV_A - 1, D_A), dt),
                                jnp.zeros((Bp, D_A), dt),
                                jnp.zeros((Bp, CONV_B - 1, D_B), dt), *params)
        xs, a2, h2, b2 = _layer(xs, c_sample, cache_conv_a[l], state_lru[l], cache_conv_b[l], *params)
        ca_p.append(a1); h_p.append(h1); cb_p.append(b1)
        ca_s.append(a2); h_s.append(h2); cb_s.append(b2)
    y_prompt = _rmsnorm_f32(xp, g_final).astype(dt)
    y_sample = _rmsnorm_f32(xs, g_final).astype(x_sample.dtype)
    conv_a_prompt = jnp.stack(ca_p)
    lru_prompt = jnp.stack(h_p)
    conv_b_prompt = jnp.stack(cb_p)
    conv_a_sample = jnp.stack(ca_s)
    lru_sample = jnp.stack(h_s)
    conv_b_sample = jnp.stack(cb_s)
    return (y_prompt, y_sample, conv_a_prompt, lru_prompt, conv_b_prompt, conv_a_sample, lru_sample, conv_b_sample)
```

```cpp
#include <hip/hip_cooperative_groups.h>
#include <cstdio>
#include <cstdint>
namespace cg = cooperative_groups;
#include <hip/hip_runtime.h>
namespace pg8 {
#define PG8_LAS __attribute__((address_space(3)))
typedef unsigned short bf16_t;
typedef short bf16x8 __attribute__((ext_vector_type(8)));
typedef float f32x4 __attribute__((ext_vector_type(4)));
typedef unsigned u32x4 __attribute__((ext_vector_type(4)));
constexpr int BM = 256, BK = 64, HALF = 128, HTB = HALF * BK * 2  , STAGE_BYTES = 8 * HTB, NXCD = 8, WGM = 8;

__host__ __device__ __forceinline__ int lds_byte(int r, int c) { const int st = (r >> 4) * 2 + (c >> 5), rr = r & 15, cc = c & 31, ob = rr * 64 + cc * 2; return st * 1024 + (ob ^ (((ob >> 9) & 1) << 5)); }
__host__ __device__ __forceinline__ void stage_rc(int b, int& R, int& C) { const int st = b / 1024, sb = b % 1024, swz = sb ^ (((sb >> 9) & 1) << 5); R = (st >> 1) * 16 + swz / 64; C = (st & 1) * 32 + (swz % 64) / 2; }
__host__ __device__ __forceinline__ int perm32(int rho) { const int n = rho >> 4, i = rho & 15; return 8 * (i >> 2) + 4 * n + (i & 3); }

struct Unit { int pm, pn; };
struct Gemm { const bf16_t* A; const bf16_t* Bt; int M, N, K; };

struct StaticOrder {
    int nM, nN, nwg, G, c;
    __host__ __device__ void init(int M, int N, int G_, int c_) { nM = M / BM; nN = N / BM; nwg = nM * nN; G = G_; c = c_; }
    __host__ __device__ bool next(int i, Unit& u) const {
        const long L = (long)i * G + c; if (L >= nwg) return false;
        int wgid = (int)L; { const int q = nwg / NXCD, r = nwg % NXCD, xcd = wgid % NXCD, off = wgid / NXCD; wgid = (xcd < r ? xcd * (q + 1) : r * (q + 1) + (xcd - r) * q) + off; }
        const int nig = WGM * nN, gid = wgid / nig, fm = gid * WGM, gsz = (nM - fm) < WGM ? (nM - fm) : WGM;
        u.pm = fm + ((wgid % nig) % gsz); u.pn = (wgid % nig) / gsz; return true;
    }
    __device__ __forceinline__ void a_ready(const Unit&) const {}
    __device__ __forceinline__ void done(const Unit&) const {}
};
__device__ __forceinline__ unsigned cvt_pk_bf16(float lo, float hi) { unsigned r; asm volatile("v_cvt_pk_bf16_f32 %0, %1, %2" : "=v"(r) : "v"(lo), "v"(hi)); return r; }
struct EpiBf16 {
    static constexpr bool PERM = true, AFTER_DRAIN = false;
    bf16_t* O; int ldc;
    __device__ __forceinline__ void operator()(const f32x4 (&acc)[2][2][4][2], const Unit& u, int wr, int wc, int fr, int fq) const {
        const int row0 = u.pm * BM + wr * 64 + fr; const int col0 = u.pn * BM + wc * 32 + 8 * fq;
#pragma unroll
        for (int ai = 0; ai < 2; ++ai)
#pragma unroll
            for (int m = 0; m < 4; ++m) { bf16_t* rowp = O + (size_t)(row0 + ai * HALF + m * 16) * ldc + col0;
#pragma unroll
                for (int bj = 0; bj < 2; ++bj) { const f32x4 v0 = acc[ai][bj][m][0], v1 = acc[ai][bj][m][1];
                    u32x4 w; w.x = cvt_pk_bf16(v0[0], v0[1]); w.y = cvt_pk_bf16(v0[2], v0[3]); w.z = cvt_pk_bf16(v1[0], v1[1]); w.w = cvt_pk_bf16(v1[2], v1[3]);
                    *(u32x4*)(rowp + bj * HALF) = w; } }
    }
};
struct EpiRes {
    static constexpr bool PERM = false, AFTER_DRAIN = false;
    const float* xp; const float* xs; const float* ada; float* out; float* rss;
    __device__ __forceinline__ void operator()(const f32x4 (&acc)[2][2][4][2], const Unit& u, int wr, int wc, int fr, int fq) const {
        const int col0 = u.pn * BM + wc * 32 + 4 * fq;
#pragma unroll
        for (int ai = 0; ai < 2; ++ai)
#pragma unroll
            for (int m = 0; m < 4; ++m) {
                const int row = u.pm * BM + ai * HALF + wr * 64 + m * 16 + fr;
                const float* xr = row < 65536 ? xp + (size_t)row * 1024 : xs + (size_t)(row - 65536) * 1024;
                const int b = row < 65536 ? (row >> 13) : 8 + ((row - 65536) >> 4);
                const float* gr = ada + (size_t)b * 3072 + 2048;
                float* orow = out + (size_t)row * 1024;
                float s = 0.f;
#pragma unroll
                for (int bj = 0; bj < 2; ++bj)
#pragma unroll
                    for (int n = 0; n < 2; ++n) { const int c = col0 + bj * HALF + n * 16;
                        const f32x4 xv = *(const f32x4*)(xr + c), gv = *(const f32x4*)(gr + c);
                        const f32x4 o = xv + gv * acc[ai][bj][m][n];
                        *(f32x4*)(orow + c) = o; s += o[0] * o[0] + o[1] * o[1] + o[2] * o[2] + o[3] * o[3]; }
                s += __shfl_xor(s, 16); s += __shfl_xor(s, 32);
                if (fq == 0) rss[(size_t)row * 16 + u.pn * 4 + wc] = s;
            }
    }
};
template <class Epi, class Sched, bool STAMP = false>
__device__ __forceinline__ void gemm_phase(PG8_LAS unsigned char* lds, const Gemm g, const Sched& S, const Epi& E, unsigned long long* stamps) {
    const int tid = threadIdx.x, wid = __builtin_amdgcn_readfirstlane(tid >> 6), lane = tid & 63, wr = wid >> 2, wc = wid & 3, fr = lane & 15, fq = lane >> 4;
    const int K = g.K, nt = K / BK;
    int ts_lo = 0, ts_hi = 0, nts = 0; const unsigned long long rt_entry = STAMP ? (unsigned long long)wall_clock64() : 0ull;
#define PG8_STAMP() do { if (STAMP && wid == 0 && nts < 64) { const unsigned long long _c = (unsigned long long)clock64(); \
        ts_lo = (lane == nts) ? (int)(unsigned)_c : ts_lo; ts_hi = (lane == nts) ? (int)(unsigned)(_c >> 32) : ts_hi; ++nts; } } while (0)
    PG8_STAMP();
    unsigned voffA[2], voffB[2];
#pragma unroll
    for (int i = 0; i < 2; ++i) { int R, C; stage_rc(tid * 16 + i * 8192, R, C); const int Rb = Epi::PERM ? ((R & ~31) + perm32(R & 31)) : R;
        voffA[i] = (unsigned)(R * K + C) * 2u; voffB[i] = (unsigned)(Rb * K + C) * 2u; }
    const size_t kstep = (size_t)(BK * 2);
    const size_t hstep = (size_t)HALF * K * 2;
    const size_t tstep = 2 * hstep;
    const unsigned ldsw = (unsigned)wid * 1024u;
    const int aoff = lds_byte(wr * 64 + fr, fq * 8), boff = lds_byte(wc * 32 + fr, fq * 8);
#define PG8_SA(b, h) (((b) * 2 + (h)) * HTB)
#define PG8_SB(b, h) ((4 + (b) * 2 + (h)) * HTB)
#define PG8_STAGE(bufoff, gbase, voff) do { _Pragma("unroll") for (int _i = 0; _i < 2; ++_i) \
        __builtin_amdgcn_global_load_lds((const unsigned*)((const char*)(gbase) + (voff)[_i]), (PG8_LAS unsigned*)(lds + (bufoff) + ldsw + _i * 8192), 16, 0, 0); } while (0)
#define PG8_LDA(dst, b, h) do { _Pragma("unroll") for (int m = 0; m < 4; ++m) _Pragma("unroll") for (int k = 0; k < 2; ++k) dst[m][k] = *(const PG8_LAS bf16x8*)(lds + PG8_SA(b, h) + aoff + m * 2048 + k * 1024); } while (0)
#define PG8_LDB(dst, b, h) do { _Pragma("unroll") for (int n = 0; n < 2; ++n) _Pragma("unroll") for (int k = 0; k < 2; ++k) dst[n][k] = *(const PG8_LAS bf16x8*)(lds + PG8_SB(b, h) + boff + n * 2048 + k * 1024); } while (0)
#define PG8_MMA(ai, bj, At, Bt) do { __builtin_amdgcn_s_setprio(1); _Pragma("unroll") for (int m = 0; m < 4; ++m) _Pragma("unroll") for (int n = 0; n < 2; ++n) _Pragma("unroll") for (int k = 0; k < 2; ++k) \
        acc[ai][bj][m][n] = __builtin_amdgcn_mfma_f32_16x16x32_bf16(Bt[n][k], At[m][k], acc[ai][bj][m][n], 0, 0, 0); __builtin_amdgcn_s_setprio(0); } while (0)
#define PG8_WAIT_V(n) asm volatile("s_waitcnt vmcnt(" #n ")" ::: "memory")
#define PG8_WAIT_L(n) asm volatile("s_waitcnt lgkmcnt(" #n ")" ::: "memory")
#define PG8_BAR __builtin_amdgcn_s_barrier()
#define PG8_SCHED __builtin_amdgcn_sched_barrier(0)
    Unit cur, nxt; int ui = 0;
    if (!S.next(0, cur)) return;
    f32x4 acc[2][2][4][2];
#pragma unroll
    for (int a = 0; a < 2; ++a)
#pragma unroll
        for (int b = 0; b < 2; ++b)
#pragma unroll
            for (int m = 0; m < 4; ++m)
#pragma unroll
                for (int n = 0; n < 2; ++n) acc[a][b][m][n] = (f32x4){0.f, 0.f, 0.f, 0.f};
    bf16x8 At[4][2], B0[2][2], B1[2][2];
    const char* cA = (const char*)g.A + (size_t)cur.pm * tstep; const char* cB = (const char*)g.Bt + (size_t)cur.pn * tstep;
    S.a_ready(cur);
    PG8_STAGE(PG8_SB(0, 0), cB, voffB); PG8_STAGE(PG8_SA(0, 0), cA, voffA); PG8_STAGE(PG8_SB(0, 1), cB + hstep, voffB); PG8_STAGE(PG8_SA(0, 1), cA + hstep, voffA);
    if (wr == 1) PG8_BAR;
    PG8_WAIT_V(4); PG8_BAR;
    PG8_STAGE(PG8_SB(1, 0), cB + kstep, voffB); PG8_STAGE(PG8_SA(1, 0), cA + kstep, voffA); PG8_STAGE(PG8_SB(1, 1), cB + hstep + kstep, voffB);
    PG8_WAIT_V(6); PG8_BAR;
    PG8_STAMP();
    for (;;) {
        const bool has_next = S.next(ui + 1, nxt);
        const char* nA = has_next ? (const char*)g.A + (size_t)nxt.pm * tstep : cA; const char* nB = has_next ? (const char*)g.Bt + (size_t)nxt.pn * tstep : cB;
        for (int t = 0; t < nt; t += 2) {
            const bool last = (t == nt - 2);
            const char* a1 = cA + (size_t)(t + 1) * kstep;
            const char* a2 = last ? nA : cA + (size_t)(t + 2) * kstep; const char* b2 = last ? nB : cB + (size_t)(t + 2) * kstep;
            const char* a3 = a2 + kstep; const char* b3 = b2 + kstep;
            if (last && has_next) S.a_ready(nxt);
            PG8_LDB(B0, 0, 0); PG8_SCHED; PG8_LDA(At, 0, 0); PG8_STAGE(PG8_SA(1, 1), a1 + hstep, voffA);
            PG8_WAIT_L(8); PG8_BAR; PG8_WAIT_L(0); PG8_MMA(0, 0, At, B0); PG8_BAR; PG8_SCHED;
            PG8_LDB(B1, 0, 1); PG8_STAGE(PG8_SB(0, 0), b2, voffB);
            PG8_BAR; PG8_WAIT_L(0); PG8_MMA(0, 1, At, B1); PG8_BAR;
            PG8_LDA(At, 0, 1); PG8_STAGE(PG8_SA(0, 0), a2, voffA);
            PG8_BAR; PG8_WAIT_L(0); PG8_MMA(1, 0, At, B0); PG8_BAR; PG8_SCHED;
            PG8_STAGE(PG8_SB(0, 1), b2 + hstep, voffB);
            PG8_WAIT_V(6); PG8_BAR; PG8_MMA(1, 1, At, B1); PG8_BAR;
            PG8_LDB(B0, 1, 0); PG8_SCHED; PG8_LDA(At, 1, 0); PG8_STAGE(PG8_SA(0, 1), a2 + hstep, voffA);
            PG8_WAIT_L(8); PG8_BAR; PG8_WAIT_L(0); PG8_MMA(0, 0, At, B0); PG8_BAR; PG8_SCHED;
            PG8_LDB(B1, 1, 1); PG8_STAGE(PG8_SB(1, 0), b3, voffB);
            PG8_BAR; PG8_WAIT_L(0); PG8_MMA(0, 1, At, B1); PG8_BAR;
            PG8_LDA(At, 1, 1); PG8_STAGE(PG8_SA(1, 0), a3, voffA);
            PG8_BAR; PG8_WAIT_L(0); PG8_MMA(1, 0, At, B0); PG8_BAR; PG8_SCHED;
            PG8_STAGE(PG8_SB(1, 1), b3 + hstep, voffB);
            PG8_WAIT_V(6); PG8_BAR; PG8_MMA(1, 1, At, B1); PG8_BAR;
        }
        PG8_STAMP();
        if constexpr (!Epi::AFTER_DRAIN) { E(acc, cur, wr, wc, fr, fq); S.done(cur); }
        PG8_STAMP();
        if (!has_next) break;
#pragma unroll
        for (int a = 0; a < 2; ++a)
#pragma unroll
            for (int b = 0; b < 2; ++b)
#pragma unroll
                for (int m = 0; m < 4; ++m)
#pragma unroll
                    for (int n = 0; n < 2; ++n) acc[a][b][m][n] = (f32x4){0.f, 0.f, 0.f, 0.f};
        cur = nxt; cA = nA; cB = nB; ++ui;
    }
    PG8_WAIT_V(0);
    if (wr == 0) PG8_BAR;
    PG8_BAR;
    if constexpr (Epi::AFTER_DRAIN) { E.fused(acc, cur, wr, wc, fr, fq, lds, wid, lane); S.done(cur); }
    PG8_STAMP();
    if (STAMP && wid == 0) { stamps[lane] = lane < nts ? (((unsigned long long)(unsigned)ts_hi << 32) | (unsigned)ts_lo) : 0ull;
        if (lane == 62) stamps[62] = rt_entry; if (lane == 63) stamps[63] = (unsigned long long)wall_clock64(); }
#undef PG8_STAMP
#undef PG8_SA
#undef PG8_SB
#undef PG8_STAGE
#undef PG8_LDA
#undef PG8_LDB
#undef PG8_MMA
#undef PG8_WAIT_V
#undef PG8_WAIT_L
#undef PG8_BAR
#undef PG8_SCHED
}
}
#define LAS __attribute__((address_space(3)))
typedef unsigned short bf16_t;
typedef short bf16x8 __attribute__((ext_vector_type(8)));
typedef float f32x4 __attribute__((ext_vector_type(4)));
typedef unsigned u32x4 __attribute__((ext_vector_type(4)));

constexpr int MP = 65536, MS = 512, MT = 66048;
constexpr int NTHR = 512, NWV = 8;
constexpr size_t al256(size_t x) { return (x + 255) & ~(size_t)255; }
constexpr size_t WS_ADA  = 0;
constexpr size_t WS_BT1  = al256(WS_ADA + 40 * 3072 * 4);
constexpr size_t WS_BT2  = al256(WS_BT1 + (size_t)4096 * 1024 * 2);
constexpr size_t WS_WG   = al256(WS_BT2 + (size_t)1024 * 1536 * 2);
constexpr size_t WS_AGG  = al256(WS_WG + 131072 * 2);
constexpr size_t WS_RSS  = al256(WS_AGG + (size_t)8 * 16 * 1024 * 2 * 4);
constexpr size_t WS_HN   = al256(WS_RSS + (size_t)MT * 16 * 4);
constexpr size_t WS_PROJ = al256(WS_HN + (size_t)MT * 1024 * 2);
constexpr size_t WS_YMIX = al256(WS_PROJ + (size_t)MT * 4096 * 2);
constexpr size_t WS_END  = al256(WS_YMIX + (size_t)MT * 1536 * 2);
constexpr size_t O_Y = 0, O_CAP = (size_t)MT * 1024, O_LRP = O_CAP + 8 * 3 * 1024, O_CBP = O_LRP + 8 * 1024, O_CAS = O_CBP + 8 * 2 * 512,
                 O_LRS = O_CAS + 32 * 3 * 1024, O_CBS = O_LRS + 32 * 1024, O_END = O_CBS + 32 * 2 * 512;

struct Args {
    const float *xp, *xs, *cp, *cs, *cache_a, *state, *cache_b, *g_norm, *w_ada, *b_ada, *w_in, *w_conv_a, *b_conv_a, *w_rg, *b_rg, *w_ig, *b_ig, *lam, *w_conv_b, *w_out, *g_final;
    float* out; unsigned char* ws; int ph_lo, ph_hi;
};

__device__ __forceinline__ float bf_lo(unsigned u) { return __uint_as_float(u << 16); }
__device__ __forceinline__ float bf_hi(unsigned u) { return __uint_as_float(u & 0xffff0000u); }
__device__ __forceinline__ void unpack8(const u32x4 v, float* f) { f[0] = bf_lo(v.x); f[1] = bf_hi(v.x); f[2] = bf_lo(v.y); f[3] = bf_hi(v.y); f[4] = bf_lo(v.z); f[5] = bf_hi(v.z); f[6] = bf_lo(v.w); f[7] = bf_hi(v.w); }
__device__ __forceinline__ u32x4 pack8(const float* f) { u32x4 w; w.x = pg8::cvt_pk_bf16(f[0], f[1]); w.y = pg8::cvt_pk_bf16(f[2], f[3]); w.z = pg8::cvt_pk_bf16(f[4], f[5]); w.w = pg8::cvt_pk_bf16(f[6], f[7]); return w; }
__device__ __forceinline__ float sigmoidf_(float x) { return __builtin_amdgcn_rcpf(1.f + __builtin_amdgcn_exp2f(-1.44269504f * x)); }
template <int CTRL> __device__ __forceinline__ float dpp_keep(float old, float src) { return __int_as_float(__builtin_amdgcn_update_dpp(__float_as_int(old), __float_as_int(src), CTRL, 0xF, 0xF, false)); }

__device__ void p0_prologue(const Args& a, LAS unsigned char* lds) {
    const int tid = threadIdx.x, bx = blockIdx.x, G = gridDim.x;
    float* ada = (float*)(a.ws + WS_ADA);
    for (int it = bx; it < 192; it += G) {
        LAS float* sS = (LAS float*)lds; LAS float* red = (LAS float*)(lds + 40 * 256 * 4);
        const int n0 = it * 16, kq = tid >> 4, col = tid & 15;
        float acc[40];
#pragma unroll
        for (int b = 0; b < 40; ++b) acc[b] = 0.f;
        for (int kc = 0; kc < 4; ++kc) {
            __syncthreads();
            for (int i = tid; i < 40 * 256; i += NTHR) { const int b = i >> 8, kk = i & 255;
                const float cv = b < 8 ? a.cp[b * 1024 + kc * 256 + kk] : a.cs[(b - 8) * 1024 + kc * 256 + kk];
                sS[i] = cv * sigmoidf_(cv); }
            __syncthreads();
#pragma unroll
            for (int k8 = 0; k8 < 8; ++k8) { const float w = a.w_ada[(size_t)(kc * 256 + kq * 8 + k8) * 3072 + n0 + col];
#pragma unroll
                for (int b = 0; b < 40; ++b) acc[b] += sS[b * 256 + kq * 8 + k8] * w; }
        }
#pragma unroll
        for (int b = 0; b < 40; ++b) red[kq * 640 + col * 40 + b] = acc[b];
        __syncthreads();
        for (int o = tid; o < 640; o += NTHR) { float s = 0.f; for (int k = 0; k < 32; ++k) s += red[k * 640 + o];
            const int c = o / 40, b = o % 40; ada[b * 3072 + n0 + c] = s + a.b_ada[n0 + c]; }
        __syncthreads();
    }
    {
        LAS float* tile = (LAS float*)lds;
        for (int tl = bx; tl < 1024 + 384; tl += G) {
            const float* src; bf16_t* dst; int K, N, kt, nt;
            if (tl < 1024) { src = a.w_in; dst = (bf16_t*)(a.ws + WS_BT1); K = 1024; N = 4096; kt = tl >> 6; nt = tl & 63; }
            else { const int t2 = tl - 1024; src = a.w_out; dst = (bf16_t*)(a.ws + WS_BT2); K = 1536; N = 1024; kt = t2 >> 4; nt = t2 & 15; }
            __syncthreads();
#pragma unroll
            for (int ps = 0; ps < 2; ++ps) { const int rr = (tid >> 4) + ps * 32, c4 = (tid & 15) * 4;
                const f32x4 v = *(const f32x4*)(src + (size_t)(kt * 64 + rr) * N + nt * 64 + c4);
                tile[rr * 65 + c4 + 0] = v[0]; tile[rr * 65 + c4 + 1] = v[1]; tile[rr * 65 + c4 + 2] = v[2]; tile[rr * 65 + c4 + 3] = v[3]; }
            __syncthreads();
            { const int n = tid >> 3, k8 = tid & 7; float f[8];
#pragma unroll
              for (int e = 0; e < 8; ++e) f[e] = tile[(k8 * 8 + e) * 65 + n];
              *(u32x4*)(dst + (size_t)(nt * 64 + n) * K + kt * 64 + k8 * 8) = pack8(f); }
        }
        __syncthreads();
    }
    {
        bf16_t* wg = (bf16_t*)(a.ws + WS_WG);
        for (int i = bx * NTHR + tid; i < 131072; i += G * NTHR) {
            const int e = i & 7, lane = (i >> 3) & 63, ks = (i >> 9) & 1, nb = (i >> 10) & 3, g = (i >> 12) & 1, h = i >> 13;
            const int m = lane & 15, q = lane >> 4;
            const int k = ks * 32 + q * 8 + e, n = (nb >> 1) * 32 + (m >> 2) * 8 + (nb & 1) * 4 + (m & 3);
            const float v = (g ? a.w_ig : a.w_rg)[(size_t)h * 4096 + k * 64 + n];
            wg[i] = (bf16_t)(pg8::cvt_pk_bf16(v, 0.f) & 0xffffu);
        }
    }
}

__device__ void p1_norm(const Args& a) {
    const int lane = threadIdx.x & 63, gw = blockIdx.x * NWV + (threadIdx.x >> 6), nw = gridDim.x * NWV;
    const float* ada = (const float*)(a.ws + WS_ADA); bf16_t* hn = (bf16_t*)(a.ws + WS_HN);
    for (int row = gw; row < MT; row += nw) {
        const float* xr = row < MP ? a.xp + (size_t)row * 1024 : a.xs + (size_t)(row - MP) * 1024;
        const int b = row < MP ? (row >> 13) : 8 + ((row - MP) >> 4);
        f32x4 v[4]; float ss = 0.f;
#pragma unroll
        for (int i = 0; i < 4; ++i) { v[i] = *(const f32x4*)(xr + (i * 64 + lane) * 4); ss += v[i][0] * v[i][0] + v[i][1] * v[i][1] + v[i][2] * v[i][2] + v[i][3] * v[i][3]; }
#pragma unroll
        for (int o = 1; o < 64; o <<= 1) ss += __shfl_xor(ss, o);
        const float rinv = rsqrtf(ss * (1.f / 1024.f) + 1e-6f);
#pragma unroll
        for (int i = 0; i < 4; ++i) { const int c = (i * 64 + lane) * 4;
            const f32x4 g = *(const f32x4*)(a.g_norm + c), sc = *(const f32x4*)(ada + b * 3072 + 1024 + c), sh = *(const f32x4*)(ada + b * 3072 + c);
            const f32x4 o = (v[i] * rinv) * g * (sc + 1.f) + sh;
            uint2 w; w.x = pg8::cvt_pk_bf16(o[0], o[1]); w.y = pg8::cvt_pk_bf16(o[2], o[3]);
            *(uint2*)(hn + (size_t)row * 1024 + c) = w; }
    }
}

template <bool APPLY>
__device__ void p3_mixer_a(const Args& a, LAS unsigned char* lds) {
    const int lane = threadIdx.x & 63, wv = threadIdx.x >> 6, gw = blockIdx.x * NWV + wv, nw = gridDim.x * NWV;
    const int r = lane & 15, q = lane >> 4;
    LAS float* tbl = (LAS float*)(lds + wv * 2048);
    const bf16_t* proj = (const bf16_t*)(a.ws + WS_PROJ); bf16_t* ymix = (bf16_t*)(a.ws + WS_YMIX);
    float* agg = (float*)(a.ws + WS_AGG);
    const int NU = APPLY ? 2560 : 2048;
    for (int u = gw; u < NU; u += nw) {
        int head, seq, chunk, nblk, tstart; size_t rowbase; bool sample, lastchunk;
        if (u < 2048) { head = u & 15; chunk = (u >> 4) & 15; seq = u >> 8; sample = false; rowbase = (size_t)seq * 8192; tstart = chunk * 512; nblk = 32; lastchunk = (chunk == 15); }
        else { const int v = u - 2048; head = v & 15; seq = v >> 4; chunk = 0; sample = true; rowbase = (size_t)MP + seq * 16; tstart = 0; nblk = 1; lastchunk = true; }
        __builtin_amdgcn_wave_barrier();
        { const int c = head * 64 + lane;
          tbl[0 * 64 + lane] = a.w_conv_a[0 * 1024 + c]; tbl[1 * 64 + lane] = a.w_conv_a[1 * 1024 + c]; tbl[2 * 64 + lane] = a.w_conv_a[2 * 1024 + c]; tbl[3 * 64 + lane] = a.w_conv_a[3 * 1024 + c];
          tbl[4 * 64 + lane] = a.b_conv_a[c]; tbl[5 * 64 + lane] = a.b_rg[c]; tbl[6 * 64 + lane] = a.b_ig[c];
          tbl[7 * 64 + lane] = -8.f * log1pf(__expf(-a.lam[c])); }
        __builtin_amdgcn_wave_barrier();
        bf16x8 wg[2][4][2];
        { const bf16x8* wgp = (const bf16x8*)(a.ws + WS_WG);
#pragma unroll
          for (int g = 0; g < 2; ++g)
#pragma unroll
            for (int nb = 0; nb < 4; ++nb)
#pragma unroll
              for (int ks = 0; ks < 2; ++ks) wg[g][nb][ks] = wgp[((((head * 2 + g) * 4 + nb) * 2 + ks) * 64) + lane]; }
        float hprev[16], ptot[16];
#pragma unroll
        for (int i = 0; i < 16; ++i) { hprev[i] = 0.f; ptot[i] = 1.f; }
        if (APPLY) {
            if (sample) {
#pragma unroll
                for (int i = 0; i < 16; ++i) hprev[i] = a.state[(size_t)seq * 1024 + head * 64 + (i >> 3) * 32 + q * 8 + (i & 7)];
            } else {
                for (int jj = 0; jj < chunk; ++jj) {
#pragma unroll
                    for (int i = 0; i < 16; ++i) { const float2 ph = *(const float2*)(agg + ((size_t)(seq * 16 + jj) * 1024 + head * 64 + (i >> 3) * 32 + q * 8 + (i & 7)) * 2);
                        hprev[i] = ph.x * hprev[i] + ph.y; }
                }
            }
        }
        for (int blk = 0; blk < nblk; ++blk) {
            const int t = tstart + blk * 16 + r;
            const size_t row = rowbase + t;
            const bool lastblk = lastchunk && (blk == nblk - 1);
            float xc[16]; bf16x8 af[2];
#pragma unroll
            for (int ks = 0; ks < 2; ++ks) {
                const int cl0 = ks * 32 + q * 8, cb = head * 64 + cl0;
                float acc8[8];
                { const f32x4 b0 = *(const LAS f32x4*)(tbl + 4 * 64 + cl0), b1 = *(const LAS f32x4*)(tbl + 4 * 64 + cl0 + 4);
                  acc8[0] = b0[0]; acc8[1] = b0[1]; acc8[2] = b0[2]; acc8[3] = b0[3]; acc8[4] = b1[0]; acc8[5] = b1[1]; acc8[6] = b1[2]; acc8[7] = b1[3]; }
#pragma unroll
                for (int kk = 0; kk < 4; ++kk) {
                    const int trel = t - 3 + kk;
                    float X[8];
                    if (trel >= 0) { unpack8(*(const u32x4*)(proj + (rowbase + trel) * 4096 + cb), X); }
                    else if (sample) { const float* cpn = a.cache_a + ((size_t)seq * 3 + (3 + trel)) * 1024 + cb; const f32x4 c0 = *(const f32x4*)cpn, c1 = *(const f32x4*)(cpn + 4);
                        X[0] = c0[0]; X[1] = c0[1]; X[2] = c0[2]; X[3] = c0[3]; X[4] = c1[0]; X[5] = c1[1]; X[6] = c1[2]; X[7] = c1[3]; }
                    else {
#pragma unroll
                        for (int e = 0; e < 8; ++e) X[e] = 0.f; }
                    const f32x4 w0 = *(const LAS f32x4*)(tbl + kk * 64 + cl0), w1 = *(const LAS f32x4*)(tbl + kk * 64 + cl0 + 4);
                    acc8[0] += w0[0] * X[0]; acc8[1] += w0[1] * X[1]; acc8[2] += w0[2] * X[2]; acc8[3] += w0[3] * X[3];
                    acc8[4] += w1[0] * X[4]; acc8[5] += w1[1] * X[5]; acc8[6] += w1[2] * X[6]; acc8[7] += w1[3] * X[7];
                    if (APPLY && kk >= 1 && lastblk && r == 15) {
                        float* o = a.out + (sample ? O_CAS : O_CAP) + ((size_t)seq * 3 + (kk - 1)) * 1024 + cb;
                        *(f32x4*)o = (f32x4){X[0], X[1], X[2], X[3]}; *(f32x4*)(o + 4) = (f32x4){X[4], X[5], X[6], X[7]}; }
                }
#pragma unroll
                for (int e = 0; e < 8; ++e) xc[ks * 8 + e] = acc8[e];
                const u32x4 pk = pack8(acc8);
                af[ks] = __builtin_bit_cast(bf16x8, pk);
            }
            f32x4 R[4], I[4];
#pragma unroll
            for (int nb = 0; nb < 4; ++nb) {
                R[nb] = __builtin_amdgcn_mfma_f32_16x16x32_bf16(wg[0][nb][0], af[0], (f32x4){0.f, 0.f, 0.f, 0.f}, 0, 0, 0);
                R[nb] = __builtin_amdgcn_mfma_f32_16x16x32_bf16(wg[0][nb][1], af[1], R[nb], 0, 0, 0);
                I[nb] = __builtin_amdgcn_mfma_f32_16x16x32_bf16(wg[1][nb][0], af[0], (f32x4){0.f, 0.f, 0.f, 0.f}, 0, 0, 0);
                I[nb] = __builtin_amdgcn_mfma_f32_16x16x32_bf16(wg[1][nb][1], af[1], I[nb], 0, 0, 0);
            }
#pragma unroll
            for (int nb = 0; nb < 4; ++nb) {
                const int ks = nb >> 1, e0 = (nb & 1) * 4, cl0 = ks * 32 + q * 8 + e0;
                const f32x4 brg = *(const LAS f32x4*)(tbl + 5 * 64 + cl0), big = *(const LAS f32x4*)(tbl + 6 * 64 + cl0), nsp = *(const LAS f32x4*)(tbl + 7 * 64 + cl0);
#pragma unroll
                for (int j = 0; j < 4; ++j) {
                    const int i16 = ks * 8 + e0 + j;
                    const float rg = sigmoidf_(R[nb][j] + brg[j]);
                    const float ig = sigmoidf_(I[nb][j] + big[j]);
                    float av = __builtin_amdgcn_exp2f(1.44269504f * nsp[j] * rg);
                    float bb = __builtin_amdgcn_sqrtf(fmaxf(1.f - av * av, 0.f)) * (ig * xc[i16]);
                    const float hr = dpp_keep<0x121>(0.f, hprev[i16]);
                    bb = (r == 0) ? fmaf(av, hr, bb) : bb;
                    { const float ap = dpp_keep<0x111>(1.f, av), bp = dpp_keep<0x111>(0.f, bb); bb = fmaf(av, bp, bb); av *= ap; }
                    { const float ap = dpp_keep<0x112>(1.f, av), bp = dpp_keep<0x112>(0.f, bb); bb = fmaf(av, bp, bb); av *= ap; }
                    { const float ap = dpp_keep<0x114>(1.f, av), bp = dpp_keep<0x114>(0.f, bb); bb = fmaf(av, bp, bb); av *= ap; }
                    { const float ap = dpp_keep<0x118>(1.f, av), bp = dpp_keep<0x118>(0.f, bb); bb = fmaf(av, bp, bb); av *= ap; }
                    hprev[i16] = bb;
                    if (!APPLY) ptot[i16] *= av;
                }
            }
            if (APPLY) {
#pragma unroll
                for (int ks = 0; ks < 2; ++ks) {
                    const int cb = head * 64 + ks * 32 + q * 8;
                    float G[8]; unpack8(*(const u32x4*)(proj + row * 4096 + 1024 + cb), G);
#pragma unroll
                    for (int e = 0; e < 8; ++e) G[e] = hprev[ks * 8 + e] * (G[e] * sigmoidf_(G[e]));
                    *(u32x4*)(ymix + row * 1536 + cb) = pack8(G);
                    if (lastblk && r == 15) { float* o = a.out + (sample ? O_LRS : O_LRP) + (size_t)seq * 1024 + cb;
                        *(f32x4*)o = (f32x4){hprev[ks * 8 + 0], hprev[ks * 8 + 1], hprev[ks * 8 + 2], hprev[ks * 8 + 3]};
                        *(f32x4*)(o + 4) = (f32x4){hprev[ks * 8 + 4], hprev[ks * 8 + 5], hprev[ks * 8 + 6], hprev[ks * 8 + 7]}; }
                }
            }
        }
        if (!APPLY) {
            if (r == 15) {
#pragma unroll
                for (int i = 0; i < 16; ++i) *(float2*)(agg + ((size_t)(seq * 16 + chunk) * 1024 + head * 64 + (i >> 3) * 32 + q * 8 + (i & 7)) * 2) = make_float2(ptot[i], hprev[i]);
            }
        }
    }
}

__device__ void p3_mixer_b(const Args& a) {
    const bf16_t* proj = (const bf16_t*)(a.ws + WS_PROJ); bf16_t* ymix = (bf16_t*)(a.ws + WS_YMIX);
    for (int it = blockIdx.x * NTHR + threadIdx.x; it < (MT / 16) * 64; it += gridDim.x * NTHR) {
        const int rb = it >> 6, cg = it & 63, c0 = cg * 8;
        const bool sample = rb >= 4096; const int seq = sample ? rb - 4096 : rb >> 9, t0 = sample ? 0 : (rb & 511) * 16;
        const size_t rowbase = sample ? (size_t)MP + seq * 16 : (size_t)seq * 8192;
        float w[3][8];
#pragma unroll
        for (int k = 0; k < 3; ++k) { const f32x4 w0 = *(const f32x4*)(a.w_conv_b + k * 512 + c0), w1 = *(const f32x4*)(a.w_conv_b + k * 512 + c0 + 4);
            w[k][0] = w0[0]; w[k][1] = w0[1]; w[k][2] = w0[2]; w[k][3] = w0[3]; w[k][4] = w1[0]; w[k][5] = w1[1]; w[k][6] = w1[2]; w[k][7] = w1[3]; }
        float vm2[8], vm1[8];
        if (t0 > 0) {
            float xa[8], ca[8];
            unpack8(*(const u32x4*)(proj + (rowbase + t0 - 2) * 4096 + 2048 + c0), xa); unpack8(*(const u32x4*)(proj + (rowbase + t0 - 2) * 4096 + 3072 + c0), ca);
#pragma unroll
            for (int e = 0; e < 8; ++e) vm2[e] = xa[e] * ca[e];
            unpack8(*(const u32x4*)(proj + (rowbase + t0 - 1) * 4096 + 2048 + c0), xa); unpack8(*(const u32x4*)(proj + (rowbase + t0 - 1) * 4096 + 3072 + c0), ca);
#pragma unroll
            for (int e = 0; e < 8; ++e) vm1[e] = xa[e] * ca[e];
        } else if (sample) {
#pragma unroll
            for (int e = 0; e < 8; ++e) { vm2[e] = a.cache_b[((size_t)seq * 2 + 0) * 512 + c0 + e]; vm1[e] = a.cache_b[((size_t)seq * 2 + 1) * 512 + c0 + e]; }
        } else {
#pragma unroll
            for (int e = 0; e < 8; ++e) { vm2[e] = 0.f; vm1[e] = 0.f; }
        }
        for (int tt = 0; tt < 16; ++tt) {
            const size_t row = rowbase + t0 + tt;
            float xb[8], cgt[8], bg[8], gb[8];
            unpack8(*(const u32x4*)(proj + row * 4096 + 2048 + c0), xb); unpack8(*(const u32x4*)(proj + row * 4096 + 2560 + c0), bg);
            unpack8(*(const u32x4*)(proj + row * 4096 + 3072 + c0), cgt); unpack8(*(const u32x4*)(proj + row * 4096 + 3584 + c0), gb);
            float y[8];
#pragma unroll
            for (int e = 0; e < 8; ++e) { const float v = cgt[e] * xb[e]; const float uu = w[0][e] * vm2[e] + w[1][e] * vm1[e] + w[2][e] * v;
                y[e] = bg[e] * uu * (gb[e] * sigmoidf_(gb[e])); vm2[e] = vm1[e]; vm1[e] = v; }
            *(u32x4*)(ymix + row * 1536 + 1024 + c0) = pack8(y);
        }
        const bool last = sample ? true : ((rb & 511) == 511);
        if (last) { float* o = a.out + (sample ? O_CBS : O_CBP) + (size_t)seq * 2 * 512 + c0;
#pragma unroll
            for (int e = 0; e < 8; ++e) { o[e] = vm2[e]; o[512 + e] = vm1[e]; } }
    }
}

__device__ void p5_final(const Args& a) {
    const int lane = threadIdx.x & 63, gw = blockIdx.x * NWV + (threadIdx.x >> 6), nw = gridDim.x * NWV;
    const float* rss = (const float*)(a.ws + WS_RSS);
    for (int row = gw; row < MT; row += nw) {
        float* yr = a.out + (size_t)row * 1024;
        float ss = lane < 16 ? rss[(size_t)row * 16 + lane] : 0.f;
#pragma unroll
        for (int o = 1; o < 16; o <<= 1) ss += __shfl_xor(ss, o);
        ss = __shfl(ss, 0);
        const float rinv = rsqrtf(ss * (1.f / 1024.f) + 1e-6f);
#pragma unroll
        for (int i = 0; i < 4; ++i) { const int c = (i * 64 + lane) * 4;
            const f32x4 v = *(const f32x4*)(yr + c), g = *(const f32x4*)(a.g_final + c);
            *(f32x4*)(yr + c) = (v * rinv) * g; }
    }
}

__global__ void __launch_bounds__(NTHR, 2) mega_fwd(Args a) {
    extern __shared__ __attribute__((aligned(16))) unsigned char lds_raw[];
    LAS unsigned char* lds = (LAS unsigned char*)lds_raw;
    cg::grid_group grid = cg::this_grid();
    const int lo = a.ph_lo, hi = a.ph_hi;
#define IN(k) (lo <= (k) && (k) < hi)
#define SEAM(k) do { if (IN(k) && IN((k) + 1)) grid.sync(); } while (0)
    if (IN(0)) p0_prologue(a, lds);
    SEAM(0);
    if (IN(1)) p1_norm(a);
    SEAM(1);
    if (IN(2)) { pg8::Gemm g{(const bf16_t*)(a.ws + WS_HN), (const bf16_t*)(a.ws + WS_BT1), MT, 4096, 1024}; pg8::StaticOrder S; S.init(MT, 4096, (int)gridDim.x, (int)blockIdx.x);
        pg8::EpiBf16 E{(bf16_t*)(a.ws + WS_PROJ), 4096};
        pg8::gemm_phase<pg8::EpiBf16, pg8::StaticOrder, false>(lds, g, S, E, nullptr); }
    SEAM(2);
    if (IN(3)) p3_mixer_a<false>(a, lds);
    SEAM(3);
    if (IN(4)) { p3_mixer_a<true>(a, lds); p3_mixer_b(a); }
    SEAM(4);
    if (IN(5)) { pg8::Gemm g{(const bf16_t*)(a.ws + WS_YMIX), (const bf16_t*)(a.ws + WS_BT2), MT, 1024, 1536}; pg8::StaticOrder S; S.init(MT, 1024, (int)gridDim.x, (int)blockIdx.x);
        pg8::EpiRes E{a.xp, a.xs, (const float*)(a.ws + WS_ADA), a.out, (float*)(a.ws + WS_RSS)};
        pg8::gemm_phase<pg8::EpiRes, pg8::StaticOrder, false>(lds, g, S, E, nullptr); }
    SEAM(5);
    if (IN(6)) p5_final(a);
#undef IN
#undef SEAM
}

#ifndef N_LAUNCHES
#define N_LAUNCHES 1
#endif
constexpr int NPH = 7, LDS_BYTES = pg8::STAGE_BYTES;

extern "C" void kernel_launch(void* const* d_in, const int* in_sizes, int n_in, void* d_out, int out_size, void* d_ws, size_t ws_size, hipStream_t stream) {
    static int grid = 0;
    if (grid == 0) {
        if (n_in != 21 || (size_t)out_size != O_END || ws_size < WS_END) { fprintf(stderr, "kernel_launch: unexpected shapes (n_in %d out %d ws %zu need %zu)\n", n_in, out_size, ws_size, (size_t)WS_END); grid = -1; return; }
        int dev = 0, cus = 0, per_cu = 0;
        hipGetDevice(&dev); hipDeviceGetAttribute(&cus, hipDeviceAttributeMultiprocessorCount, dev);
        if (hipFuncSetAttribute((const void*)mega_fwd, hipFuncAttributeMaxDynamicSharedMemorySize, LDS_BYTES) != hipSuccess) { fprintf(stderr, "kernel_launch: hipFuncSetAttribute failed\n"); grid = -1; return; }
        if (hipOccupancyMaxActiveBlocksPerMultiprocessor(&per_cu, (const void*)mega_fwd, NTHR, LDS_BYTES) != hipSuccess || per_cu < 1) { fprintf(stderr, "kernel_launch: occupancy query says %d\n", per_cu); per_cu = 1; }
        (void)hipGetLastError();
        grid = cus * 1;
    }
    if (grid < 0) return;
    Args a{};
    const float** ip = (const float**)&a;
    for (int i = 0; i < 21; ++i) ip[i] = (const float*)d_in[i];
    a.out = (float*)d_out; a.ws = (unsigned char*)d_ws;
#if N_LAUNCHES == 1
    a.ph_lo = 0; a.ph_hi = NPH;
    void* args[] = {&a};
    hipError_t e = hipLaunchCooperativeKernel((const void*)mega_fwd, dim3(grid), dim3(NTHR), args, LDS_BYTES, stream);
    if (e != hipSuccess) fprintf(stderr, "cooperative launch failed: %s (grid %d)\n", hipGetErrorString(e), grid);
#else
    for (int ph = 0; ph < NPH; ++ph) { a.ph_lo = ph; a.ph_hi = ph + 1; hipLaunchKernelGGL(mega_fwd, dim3(grid), dim3(NTHR), LDS_BYTES, stream, a); }
#endif
}
```

```cpp
#include <hip/hip_cooperative_groups.h>
#include <cstdio>
#include <cstdint>
namespace cg = cooperative_groups;
#include <hip/hip_runtime.h>
namespace pg8 {
#define PG8_LAS __attribute__((address_space(3)))
typedef unsigned short bf16_t;
typedef short bf16x8 __attribute__((ext_vector_type(8)));
typedef float f32x4 __attribute__((ext_vector_type(4)));
typedef unsigned u32x4 __attribute__((ext_vector_type(4)));
constexpr int BM = 256, BK = 64, HALF = 128, HTB = HALF * BK * 2  , STAGE_BYTES = 8 * HTB, NXCD = 8, WGM = 8;

__host__ __device__ __forceinline__ int lds_byte(int r, int c) { const int st = (r >> 4) * 2 + (c >> 5), rr = r & 15, cc = c & 31, ob = rr * 64 + cc * 2; return st * 1024 + (ob ^ (((ob >> 9) & 1) << 5)); }
__host__ __device__ __forceinline__ void stage_rc(int b, int& R, int& C) { const int st = b / 1024, sb = b % 1024, swz = sb ^ (((sb >> 9) & 1) << 5); R = (st >> 1) * 16 + swz / 64; C = (st & 1) * 32 + (swz % 64) / 2; }
__host__ __device__ __forceinline__ int perm32(int rho) { const int n = rho >> 4, i = rho & 15; return 8 * (i >> 2) + 4 * n + (i & 3); }

struct Unit { int pm, pn; };
struct Gemm { const bf16_t* A; const bf16_t* Bt; int M, N, K; };

struct StaticOrder {
    int nM, nN, nwg, G, c;
    __host__ __device__ void init(int M, int N, int G_, int c_) { nM = M / BM; nN = N / BM; nwg = nM * nN; G = G_; c = c_; }
    __host__ __device__ bool next(int i, Unit& u) const {
        const long L = (long)i * G + c; if (L >= nwg) return false;
        int wgid = (int)L; { const int q = nwg / NXCD, r = nwg % NXCD, xcd = wgid % NXCD, off = wgid / NXCD; wgid = (xcd < r ? xcd * (q + 1) : r * (q + 1) + (xcd - r) * q) + off; }
        const int nig = WGM * nN, gid = wgid / nig, fm = gid * WGM, gsz = (nM - fm) < WGM ? (nM - fm) : WGM;
        u.pm = fm + ((wgid % nig) % gsz); u.pn = (wgid % nig) / gsz; return true;
    }
    __device__ __forceinline__ void a_ready(const Unit&) const {}
    __device__ __forceinline__ void done(const Unit&) const {}
};
__device__ __forceinline__ unsigned cvt_pk_bf16(float lo, float hi) { unsigned r; asm volatile("v_cvt_pk_bf16_f32 %0, %1, %2" : "=v"(r) : "v"(lo), "v"(hi)); return r; }
struct EpiBf16 {
    static constexpr bool PERM = true, AFTER_DRAIN = false;
    bf16_t* O; int ldc;
    __device__ __forceinline__ void operator()(const f32x4 (&acc)[2][2][4][2], const Unit& u, int wr, int wc, int fr, int fq) const {
        const int row0 = u.pm * BM + wr * 64 + fr; const int col0 = u.pn * BM + wc * 32 + 8 * fq;
#pragma unroll
        for (int ai = 0; ai < 2; ++ai)
#pragma unroll
            for (int m = 0; m < 4; ++m) { bf16_t* rowp = O + (size_t)(row0 + ai * HALF + m * 16) * ldc + col0;
#pragma unroll
                for (int bj = 0; bj < 2; ++bj) { const f32x4 v0 = acc[ai][bj][m][0], v1 = acc[ai][bj][m][1];
                    u32x4 w; w.x = cvt_pk_bf16(v0[0], v0[1]); w.y = cvt_pk_bf16(v0[2], v0[3]); w.z = cvt_pk_bf16(v1[0], v1[1]); w.w = cvt_pk_bf16(v1[2], v1[3]);
                    *(u32x4*)(rowp + bj * HALF) = w; } }
    }
};
struct EpiRes {
    static constexpr bool PERM = false, AFTER_DRAIN = false;
    const float* xp; const float* xs; const float* ada; float* out; float* rss;
    __device__ __forceinline__ void operator()(const f32x4 (&acc)[2][2][4][2], const Unit& u, int wr, int wc, int fr, int fq) const {
        const int col0 = u.pn * BM + wc * 32 + 4 * fq;
#pragma unroll
        for (int ai = 0; ai < 2; ++ai)
#pragma unroll
            for (int m = 0; m < 4; ++m) {
                const int row = u.pm * BM + ai * HALF + wr * 64 + m * 16 + fr;
                const float* xr = row < 65536 ? xp + (size_t)row * 1024 : xs + (size_t)(row - 65536) * 1024;
                const int b = row < 65536 ? (row >> 13) : 8 + ((row - 65536) >> 4);
                const float* gr = ada + (size_t)b * 3072 + 2048;
                float* orow = out + (size_t)row * 1024;
                float s = 0.f;
#pragma unroll
                for (int bj = 0; bj < 2; ++bj)
#pragma unroll
                    for (int n = 0; n < 2; ++n) { const int c = col0 + bj * HALF + n * 16;
                        const f32x4 xv = *(const f32x4*)(xr + c), gv = *(const f32x4*)(gr + c);
                        const f32x4 o = xv + gv * acc[ai][bj][m][n];
                        *(f32x4*)(orow + c) = o; s += o[0] * o[0] + o[1] * o[1] + o[2] * o[2] + o[3] * o[3]; }
                s += __shfl_xor(s, 16); s += __shfl_xor(s, 32);
                if (fq == 0) rss[(size_t)row * 16 + u.pn * 4 + wc] = s;
            }
    }
};

struct EpiResNorm {
    static constexpr bool PERM = false, AFTER_DRAIN = false;
    const float* xp; const float* xs; const float* ada; const float* gfin; float* out; float* xbuf; unsigned* cnt;
    __device__ __forceinline__ void operator()(f32x4 (&acc)[2][2][4][2], const Unit& u, int wr, int wc, int fr, int fq) const {
        const int col0 = u.pn * BM + wc * 32 + 4 * fq;
#pragma unroll
        for (int ai = 0; ai < 2; ++ai)
#pragma unroll
            for (int m = 0; m < 4; ++m) {
                const int row = u.pm * BM + ai * HALF + wr * 64 + m * 16 + fr;
                const float* xr = row < 65536 ? xp + (size_t)row * 1024 : xs + (size_t)(row - 65536) * 1024;
                const int b = row < 65536 ? (row >> 13) : 8 + ((row - 65536) >> 4);
                const float* gr = ada + (size_t)b * 3072 + 2048;
                float s = 0.f;
#pragma unroll
                for (int bj = 0; bj < 2; ++bj)
#pragma unroll
                    for (int n = 0; n < 2; ++n) { const int c = col0 + bj * HALF + n * 16;
                        const f32x4 xv = *(const f32x4*)(xr + c), gv = *(const f32x4*)(gr + c);
                        const f32x4 o = xv + gv * acc[ai][bj][m][n];
                        acc[ai][bj][m][n] = o; s += o[0] * o[0] + o[1] * o[1] + o[2] * o[2] + o[3] * o[3]; }
                s += __shfl_xor(s, 16); s += __shfl_xor(s, 32);
                if (fq == 0) __hip_atomic_store(xbuf + (size_t)row * 16 + u.pn * 4 + wc, s, __ATOMIC_RELAXED, __HIP_MEMORY_SCOPE_AGENT);
            }
        asm volatile("s_waitcnt vmcnt(0)" ::: "memory");
        unsigned* c = cnt + (size_t)(u.pm * 2 + wr) * 64;
        if (fr == 0 && fq == 0) __hip_atomic_fetch_add(c, 1u, __ATOMIC_RELAXED, __HIP_MEMORY_SCOPE_AGENT);
        { const unsigned long long t0 = __builtin_amdgcn_s_memrealtime();
          while ((unsigned)__builtin_amdgcn_readfirstlane(__hip_atomic_load(c, __ATOMIC_RELAXED, __HIP_MEMORY_SCOPE_AGENT)) < 16u) {
              if (__builtin_amdgcn_s_memrealtime() - t0 > 4000000ull) break;
              __builtin_amdgcn_s_sleep(2); } }
        asm volatile("" ::: "memory");
#pragma unroll
        for (int ai = 0; ai < 2; ++ai)
#pragma unroll
            for (int m = 0; m < 4; ++m) {
                const int row = u.pm * BM + ai * HALF + wr * 64 + m * 16 + fr;
                const float* xb = xbuf + (size_t)row * 16 + fq * 4;
                float t = (__hip_atomic_load(xb, __ATOMIC_RELAXED, __HIP_MEMORY_SCOPE_AGENT) + __hip_atomic_load(xb + 1, __ATOMIC_RELAXED, __HIP_MEMORY_SCOPE_AGENT))
                        + (__hip_atomic_load(xb + 2, __ATOMIC_RELAXED, __HIP_MEMORY_SCOPE_AGENT) + __hip_atomic_load(xb + 3, __ATOMIC_RELAXED, __HIP_MEMORY_SCOPE_AGENT));
                t += __shfl_xor(t, 16); t += __shfl_xor(t, 32);
                const float rinv = rsqrtf(t * (1.f / 1024.f) + 1e-6f);
                float* orow = out + (size_t)row * 1024;
#pragma unroll
                for (int bj = 0; bj < 2; ++bj)
#pragma unroll
                    for (int n = 0; n < 2; ++n) { const int cc = col0 + bj * HALF + n * 16;
                        const f32x4 g = *(const f32x4*)(gfin + cc);
                        *(f32x4*)(orow + cc) = (acc[ai][bj][m][n] * rinv) * g; }
            }
    }
};
struct RowOrder {
    int G, c, nM;
    __host__ __device__ void init(int M, int G_, int c_) { nM = M / BM; G = G_; c = c_; }
    __host__ __device__ bool next(int i, Unit& u) const {
        int pslot, pn;
        if ((G & 31) == 0) { const int xcd = c & 7, slot = c >> 3; pslot = xcd * (G >> 5) + (slot >> 2); pn = slot & 3; }
        else { pslot = c >> 2; pn = c & 3; if (c >= (G & ~3)) return false; }
        const int pm = i * (G >> 2) + pslot; if (pm >= nM) return false;
        u.pm = pm; u.pn = pn; return true;
    }
    __device__ __forceinline__ void a_ready(const Unit&) const {}
    __device__ __forceinline__ void done(const Unit&) const {}
};

template <class Epi, class Sched, bool STAMP = false, bool ALIGN_EPI = true>
__device__ __forceinline__ void gemm_phase(PG8_LAS unsigned char* lds, const Gemm g, const Sched& S, const Epi& E, unsigned long long* stamps) {
    const int tid = threadIdx.x, wid = __builtin_amdgcn_readfirstlane(tid >> 6), lane = tid & 63, wr = wid >> 2, wc = wid & 3, fr = lane & 15, fq = lane >> 4;
    const int K = g.K, nt = K / BK;
    int ts_lo = 0, ts_hi = 0, nts = 0; const unsigned long long rt_entry = STAMP ? (unsigned long long)wall_clock64() : 0ull;
#define PG8_STAMP() do { if (STAMP && wid == 0 && nts < 64) { const unsigned long long _c = (unsigned long long)clock64(); \
        ts_lo = (lane == nts) ? (int)(unsigned)_c : ts_lo; ts_hi = (lane == nts) ? (int)(unsigned)(_c >> 32) : ts_hi; ++nts; } } while (0)
    PG8_STAMP();
    unsigned voffA[2], voffB[2];
#pragma unroll
    for (int i = 0; i < 2; ++i) { int R, C; stage_rc(tid * 16 + i * 8192, R, C); const int Rb = Epi::PERM ? ((R & ~31) + perm32(R & 31)) : R;
        voffA[i] = (unsigned)(R * K + C) * 2u; voffB[i] = (unsigned)(Rb * K + C) * 2u; }
    const size_t kstep = (size_t)(BK * 2);
    const size_t hstep = (size_t)HALF * K * 2;
    const size_t tstep = 2 * hstep;
    const unsigned ldsw = (unsigned)wid * 1024u;
    const int aoff = lds_byte(wr * 64 + fr, fq * 8), boff = lds_byte(wc * 32 + fr, fq * 8);
#define PG8_SA(b, h) (((b) * 2 + (h)) * HTB)
#define PG8_SB(b, h) ((4 + (b) * 2 + (h)) * HTB)
#define PG8_STAGE(bufoff, gbase, voff) do { _Pragma("unroll") for (int _i = 0; _i < 2; ++_i) \
        __builtin_amdgcn_global_load_lds((const unsigned*)((const char*)(gbase) + (voff)[_i]), (PG8_LAS unsigned*)(lds + (bufoff) + ldsw + _i * 8192), 16, 0, 0); } while (0)
#define PG8_LDA(dst, b, h) do { _Pragma("unroll") for (int m = 0; m < 4; ++m) _Pragma("unroll") for (int k = 0; k < 2; ++k) dst[m][k] = *(const PG8_LAS bf16x8*)(lds + PG8_SA(b, h) + aoff + m * 2048 + k * 1024); } while (0)
#define PG8_LDB(dst, b, h) do { _Pragma("unroll") for (int n = 0; n < 2; ++n) _Pragma("unroll") for (int k = 0; k < 2; ++k) dst[n][k] = *(const PG8_LAS bf16x8*)(lds + PG8_SB(b, h) + boff + n * 2048 + k * 1024); } while (0)
#define PG8_MMA(ai, bj, At, Bt) do { __builtin_amdgcn_s_setprio(1); _Pragma("unroll") for (int m = 0; m < 4; ++m) _Pragma("unroll") for (int n = 0; n < 2; ++n) _Pragma("unroll") for (int k = 0; k < 2; ++k) \
        acc[ai][bj][m][n] = __builtin_amdgcn_mfma_f32_16x16x32_bf16(Bt[n][k], At[m][k], acc[ai][bj][m][n], 0, 0, 0); __builtin_amdgcn_s_setprio(0); } while (0)
#define PG8_WAIT_V(n) asm volatile("s_waitcnt vmcnt(" #n ")" ::: "memory")
#define PG8_WAIT_L(n) asm volatile("s_waitcnt lgkmcnt(" #n ")" ::: "memory")
#define PG8_BAR __builtin_amdgcn_s_barrier()
#define PG8_SCHED __builtin_amdgcn_sched_barrier(0)
    Unit cur, nxt; int ui = 0;
    if (!S.next(0, cur)) return;
    f32x4 acc[2][2][4][2];
#pragma unroll
    for (int a = 0; a < 2; ++a)
#pragma unroll
        for (int b = 0; b < 2; ++b)
#pragma unroll
            for (int m = 0; m < 4; ++m)
#pragma unroll
                for (int n = 0; n < 2; ++n) acc[a][b][m][n] = (f32x4){0.f, 0.f, 0.f, 0.f};
    bf16x8 At[4][2], B0[2][2], B1[2][2];
    const char* cA = (const char*)g.A + (size_t)cur.pm * tstep; const char* cB = (const char*)g.Bt + (size_t)cur.pn * tstep;
    S.a_ready(cur);
    PG8_STAGE(PG8_SB(0, 0), cB, voffB); PG8_STAGE(PG8_SA(0, 0), cA, voffA); PG8_STAGE(PG8_SB(0, 1), cB + hstep, voffB); PG8_STAGE(PG8_SA(0, 1), cA + hstep, voffA);
    if (wr == 1) PG8_BAR;
    PG8_WAIT_V(4); PG8_BAR;
    PG8_STAGE(PG8_SB(1, 0), cB + kstep, voffB); PG8_STAGE(PG8_SA(1, 0), cA + kstep, voffA); PG8_STAGE(PG8_SB(1, 1), cB + hstep + kstep, voffB);
    PG8_WAIT_V(6); PG8_BAR;
    PG8_STAMP();
    for (;;) {
        const bool has_next = S.next(ui + 1, nxt);
        const char* nA = has_next ? (const char*)g.A + (size_t)nxt.pm * tstep : cA; const char* nB = has_next ? (const char*)g.Bt + (size_t)nxt.pn * tstep : cB;
        for (int t = 0; t < nt; t += 2) {
            const bool last = (t == nt - 2);
            const char* a1 = cA + (size_t)(t + 1) * kstep;
            const char* a2 = last ? nA : cA + (size_t)(t + 2) * kstep; const char* b2 = last ? nB : cB + (size_t)(t + 2) * kstep;
            const char* a3 = a2 + kstep; const char* b3 = b2 + kstep;
            if (last && has_next) S.a_ready(nxt);
            PG8_LDB(B0, 0, 0); PG8_SCHED; PG8_LDA(At, 0, 0); PG8_STAGE(PG8_SA(1, 1), a1 + hstep, voffA);
            PG8_WAIT_L(8); PG8_BAR; PG8_WAIT_L(0); PG8_MMA(0, 0, At, B0); PG8_BAR; PG8_SCHED;
            PG8_LDB(B1, 0, 1); PG8_STAGE(PG8_SB(0, 0), b2, voffB);
            PG8_BAR; PG8_WAIT_L(0); PG8_MMA(0, 1, At, B1); PG8_BAR;
            PG8_LDA(At, 0, 1); PG8_STAGE(PG8_SA(0, 0), a2, voffA);
            PG8_BAR; PG8_WAIT_L(0); PG8_MMA(1, 0, At, B0); PG8_BAR; PG8_SCHED;
            PG8_STAGE(PG8_SB(0, 1), b2 + hstep, voffB);
            PG8_WAIT_V(6); PG8_BAR; PG8_MMA(1, 1, At, B1); PG8_BAR;
            PG8_LDB(B0, 1, 0); PG8_SCHED; PG8_LDA(At, 1, 0); PG8_STAGE(PG8_SA(0, 1), a2 + hstep, voffA);
            PG8_WAIT_L(8); PG8_BAR; PG8_WAIT_L(0); PG8_MMA(0, 0, At, B0); PG8_BAR; PG8_SCHED;
            PG8_LDB(B1, 1, 1); PG8_STAGE(PG8_SB(1, 0), b3, voffB);
            PG8_BAR; PG8_WAIT_L(0); PG8_MMA(0, 1, At, B1); PG8_BAR;
            PG8_LDA(At, 1, 1); PG8_STAGE(PG8_SA(1, 0), a3, voffA);
            PG8_BAR; PG8_WAIT_L(0); PG8_MMA(1, 0, At, B0); PG8_BAR; PG8_SCHED;
            PG8_STAGE(PG8_SB(1, 1), b3 + hstep, voffB);
            PG8_WAIT_V(6); PG8_BAR; PG8_MMA(1, 1, At, B1); PG8_BAR;
        }
        PG8_STAMP();
        if constexpr (ALIGN_EPI) { if (wr == 0) PG8_BAR; }
        if constexpr (!Epi::AFTER_DRAIN) { E(acc, cur, wr, wc, fr, fq); S.done(cur); }
        PG8_STAMP();
        if (!has_next) break;
#pragma unroll
        for (int a = 0; a < 2; ++a)
#pragma unroll
            for (int b = 0; b < 2; ++b)
#pragma unroll
                for (int m = 0; m < 4; ++m)
#pragma unroll
                    for (int n = 0; n < 2; ++n) acc[a][b][m][n] = (f32x4){0.f, 0.f, 0.f, 0.f};
        cur = nxt; cA = nA; cB = nB; ++ui;
        if constexpr (ALIGN_EPI) { if (wr == 1) PG8_BAR; }
    }
    PG8_WAIT_V(0);
    if constexpr (!ALIGN_EPI) { if (wr == 0) PG8_BAR; }
    PG8_BAR;
    if constexpr (Epi::AFTER_DRAIN) { E.fused(acc, cur, wr, wc, fr, fq, lds, wid, lane); S.done(cur); }
    PG8_STAMP();
    if (STAMP && wid == 0) { stamps[lane] = lane < nts ? (((unsigned long long)(unsigned)ts_hi << 32) | (unsigned)ts_lo) : 0ull;
        if (lane == 62) stamps[62] = rt_entry; if (lane == 63) stamps[63] = (unsigned long long)wall_clock64(); }
#undef PG8_STAMP
#undef PG8_SA
#undef PG8_SB
#undef PG8_STAGE
#undef PG8_LDA
#undef PG8_LDB
#undef PG8_MMA
#undef PG8_WAIT_V
#undef PG8_WAIT_L
#undef PG8_BAR
#undef PG8_SCHED
}
}
#define LAS __attribute__((address_space(3)))
#define XB_TMO      128
#define XB_XCNT(j)  (256  + 64 * (j))
#define XB_XSUB(j)  (1280 + 64 * (j))
#define XB_XGEN(j)  (2304 + 64 * (j))
#define XB_TOP      3328
#define XB_TOPGEN   3392
#define XCD_BAR_WORDS 3456
#define XB_SPIN_CAP (1u << 18)
typedef unsigned short bf16_t;
typedef short bf16x8 __attribute__((ext_vector_type(8)));
typedef float f32x4 __attribute__((ext_vector_type(4)));
typedef unsigned u32x4 __attribute__((ext_vector_type(4)));

constexpr int MP = 65536, MS = 512, MT = 66048;
constexpr int NTHR = 512, NWV = 8;
constexpr size_t al256(size_t x) { return (x + 255) & ~(size_t)255; }
constexpr size_t WS_ADA  = 0;
constexpr size_t WS_BT1  = al256(WS_ADA + 40 * 3072 * 4);
constexpr size_t WS_BT2  = al256(WS_BT1 + (size_t)4096 * 1024 * 2);
constexpr size_t WS_WG   = al256(WS_BT2 + (size_t)1024 * 1536 * 2);
constexpr size_t WS_AGG  = al256(WS_WG + 131072 * 2);
constexpr size_t WS_BAR  = al256(WS_AGG + (size_t)8 * 16 * 1024 * 2 * 4);
constexpr size_t WS_CNT  = al256(WS_BAR + XCD_BAR_WORDS * 4);
constexpr size_t WS_RSS  = al256(WS_CNT + (size_t)258 * 2 * 256);
constexpr size_t WS_HN   = al256(WS_RSS + (size_t)MT * 16 * 4);
constexpr size_t WS_LB   = WS_HN;
constexpr size_t WS_PROJ = al256(WS_HN + (size_t)MT * 1024 * 4);
constexpr size_t WS_YMIX = al256(WS_PROJ + (size_t)MT * 4096 * 2);
constexpr size_t WS_OM   = WS_HN;
constexpr size_t WS_END  = al256(WS_YMIX + (size_t)MT * 1536 * 2);
constexpr size_t O_Y = 0, O_CAP = (size_t)MT * 1024, O_LRP = O_CAP + 8 * 3 * 1024, O_CBP = O_LRP + 8 * 1024, O_CAS = O_CBP + 8 * 2 * 512,
                 O_LRS = O_CAS + 32 * 3 * 1024, O_CBS = O_LRS + 32 * 1024, O_END = O_CBS + 32 * 2 * 512;

struct Args {
    const float *xp, *xs, *cp, *cs, *cache_a, *state, *cache_b, *g_norm, *w_ada, *b_ada, *w_in, *w_conv_a, *b_conv_a, *w_rg, *b_rg, *w_ig, *b_ig, *lam, *w_conv_b, *w_out, *g_final;
    float* out; unsigned char* ws; int ph_lo, ph_hi;
};

__device__ __forceinline__ float bf_lo(unsigned u) { return __uint_as_float(u << 16); }
__device__ __forceinline__ float bf_hi(unsigned u) { return __uint_as_float(u & 0xffff0000u); }
__device__ __forceinline__ void unpack8(const u32x4 v, float* f) { f[0] = bf_lo(v.x); f[1] = bf_hi(v.x); f[2] = bf_lo(v.y); f[3] = bf_hi(v.y); f[4] = bf_lo(v.z); f[5] = bf_hi(v.z); f[6] = bf_lo(v.w); f[7] = bf_hi(v.w); }
__device__ __forceinline__ u32x4 pack8(const float* f) { u32x4 w; w.x = pg8::cvt_pk_bf16(f[0], f[1]); w.y = pg8::cvt_pk_bf16(f[2], f[3]); w.z = pg8::cvt_pk_bf16(f[4], f[5]); w.w = pg8::cvt_pk_bf16(f[6], f[7]); return w; }
__device__ __forceinline__ float sigmoidf_(float x) { return __builtin_amdgcn_rcpf(1.f + __builtin_amdgcn_exp2f(-1.44269504f * x)); }
template <int CTRL> __device__ __forceinline__ float dpp_keep(float old, float src) { return __int_as_float(__builtin_amdgcn_update_dpp(__float_as_int(old), __float_as_int(src), CTRL, 0xF, 0xF, false)); }


__device__ __forceinline__ unsigned xb_ld(unsigned* p)              { return __hip_atomic_load(p, __ATOMIC_RELAXED, __HIP_MEMORY_SCOPE_AGENT); }
__device__ __forceinline__ unsigned xb_add(unsigned* p, unsigned v) { return __hip_atomic_fetch_add(p, v, __ATOMIC_RELAXED, __HIP_MEMORY_SCOPE_AGENT); }
__device__ __forceinline__ unsigned xb_xcc_id() { return (unsigned)__builtin_amdgcn_s_getreg((3 << 11) | 20) & 0xFu; }
#define XB_SPIN(cond, bar) do { unsigned _sp = 0; while (cond) { __builtin_amdgcn_s_sleep(1); \
    if ((++_sp & 255u) == 0u) { if (xb_ld(&(bar)[XB_TMO])) break; if (_sp > XB_SPIN_CAP) { atomicAdd(&(bar)[XB_TMO], 1u); break; } } } } while (0)
struct XcdBarrier {
    unsigned* bar; unsigned x;
    volatile LAS unsigned* st;
};

__device__ __forceinline__ XcdBarrier xcd_barrier_post(unsigned* bar, volatile LAS unsigned* st) {
    XcdBarrier b; b.bar = bar; b.x = xb_xcc_id(); b.st = st;
    if (threadIdx.x == 0) (void)xb_add(&bar[XB_XCNT(b.x)], 1u);
    return b;
}
__device__ __forceinline__ void xcd_barrier_complete(unsigned* bar, unsigned x, unsigned& nloc, unsigned& nx) {
    const unsigned G = gridDim.x * gridDim.y * gridDim.z;
    unsigned sum, cnt, mine, sp = 0u;
    for (;;) {
        sum = 0u; cnt = 0u; mine = 0u;
#pragma unroll
        for (unsigned j = 0; j < 16; ++j) { const unsigned c = xb_ld(&bar[XB_XCNT(j)]); sum += c; cnt += (c > 0u) ? 1u : 0u; mine = (j == x) ? c : mine; }
        if (sum == G) break;
        __builtin_amdgcn_s_sleep(1);
        if ((++sp & 255u) == 0u) { if (xb_ld(&bar[XB_TMO])) break; if (sp > XB_SPIN_CAP) { atomicAdd(&bar[XB_TMO], 1u); break; } }
    }
    nloc = mine > 0u ? mine : 1u; nx = cnt > 0u ? cnt : 1u;
}

__device__ __forceinline__ void xcd_barrier(const XcdBarrier& b) {
    asm volatile("s_waitcnt vmcnt(0)" ::: "memory");
    __syncthreads();
    if (threadIdx.x == 0) {
        unsigned* bar = b.bar;
        __builtin_amdgcn_s_waitcnt(0);
        unsigned nloc = b.st[0], nx = b.st[1];
        if (nloc == 0u) { xcd_barrier_complete(bar, b.x, nloc, nx); b.st[0] = nloc; b.st[1] = nx; }
        const unsigned old = xb_add(&bar[XB_XSUB(b.x)], 1u);
        const unsigned gen = old / nloc;
        if (old + 1u == (gen + 1u) * nloc) {
            __builtin_amdgcn_fence(__ATOMIC_RELEASE, "agent");
            asm volatile("s_waitcnt vmcnt(0)" ::: "memory");
            const unsigned og = xb_add(&bar[XB_TOP], 1u);
            const unsigned tg = og / nx;
            if (og + 1u == (tg + 1u) * nx) xb_add(&bar[XB_TOPGEN], 1u);
            else XB_SPIN(xb_ld(&bar[XB_TOPGEN]) == tg, bar);
            __builtin_amdgcn_fence(__ATOMIC_ACQUIRE, "agent");
            xb_add(&bar[XB_XGEN(b.x)], 1u);
            asm volatile("s_waitcnt vmcnt(0)" ::: "memory");
        } else {
            XB_SPIN(xb_ld(&bar[XB_XGEN(b.x)]) == gen, bar);
            __builtin_amdgcn_fence(__ATOMIC_ACQUIRE, "agent");
            asm volatile("s_waitcnt vmcnt(0)" ::: "memory");
        }
    }
    __syncthreads();
}

#define XB_REC_WORDS 32

__device__ __forceinline__ void scan4(float& a0, float& a1, float& a2, float& a3, float& b0, float& b1, float& b2, float& b3, float h0, float h1, float h2, float h3) {
#define DPPM " row_mask:0xf bank_mask:0xf\n\t"
#define STEP(N) "v_fmac_f32_dpp %4, %4, %0 row_shr:" #N DPPM "v_fmac_f32_dpp %5, %5, %1 row_shr:" #N DPPM "v_fmac_f32_dpp %6, %6, %2 row_shr:" #N DPPM "v_fmac_f32_dpp %7, %7, %3 row_shr:" #N DPPM \
                "v_mul_f32_dpp %0, %0, %0 row_shr:" #N DPPM "v_mul_f32_dpp %1, %1, %1 row_shr:" #N DPPM "v_mul_f32_dpp %2, %2, %2 row_shr:" #N DPPM "v_mul_f32_dpp %3, %3, %3 row_shr:" #N DPPM
    asm volatile("s_nop 1\n\t"
        "v_fmac_f32_dpp %4, %8, %0 row_ror:1" DPPM "v_fmac_f32_dpp %5, %9, %1 row_ror:1" DPPM "v_fmac_f32_dpp %6, %10, %2 row_ror:1" DPPM "v_fmac_f32_dpp %7, %11, %3 row_ror:1" DPPM
        STEP(1) STEP(2) STEP(4) STEP(8)
        : "+v"(a0), "+v"(a1), "+v"(a2), "+v"(a3), "+v"(b0), "+v"(b1), "+v"(b2), "+v"(b3) : "v"(h0), "v"(h1), "v"(h2), "v"(h3));
#undef STEP
#undef DPPM
}

__device__ void p0_prologue(const Args& a, LAS unsigned char* lds) {
    const int tid = threadIdx.x, bx = blockIdx.x, G = gridDim.x;
    float* ada = (float*)(a.ws + WS_ADA);
    { unsigned* cz = (unsigned*)(a.ws + WS_CNT); for (int i = bx * NTHR + tid; i < 258 * 2 * 64; i += G * NTHR) cz[i] = 0u; }
    for (int it = bx; it < 192; it += G) {
        LAS float* sS = (LAS float*)lds; LAS float* red = (LAS float*)(lds + 40 * 256 * 4);
        const int n0 = it * 16, kq = tid >> 4, col = tid & 15;
        float acc[40];
#pragma unroll
        for (int b = 0; b < 40; ++b) acc[b] = 0.f;
        for (int kc = 0; kc < 4; ++kc) {
            __syncthreads();
            for (int i = tid; i < 40 * 256; i += NTHR) { const int b = i >> 8, kk = i & 255;
                const float cv = b < 8 ? a.cp[b * 1024 + kc * 256 + kk] : a.cs[(b - 8) * 1024 + kc * 256 + kk];
                sS[i] = cv * sigmoidf_(cv); }
            __syncthreads();
#pragma unroll
            for (int k8 = 0; k8 < 8; ++k8) { const float w = a.w_ada[(size_t)(kc * 256 + kq * 8 + k8) * 3072 + n0 + col];
#pragma unroll
                for (int b = 0; b < 40; ++b) acc[b] += sS[b * 256 + kq * 8 + k8] * w; }
        }
#pragma unroll
        for (int b = 0; b < 40; ++b) red[kq * 640 + col * 40 + b] = acc[b];
        __syncthreads();
        for (int o = tid; o < 640; o += NTHR) { float s = 0.f; for (int k = 0; k < 32; ++k) s += red[k * 640 + o];
            const int c = o / 40, b = o % 40; ada[b * 3072 + n0 + c] = s + a.b_ada[n0 + c]; }
        __syncthreads();
    }
    {
        LAS float* tile = (LAS float*)lds;
        for (int tl = bx; tl < 1024 + 384; tl += G) {
            const float* src; bf16_t* dst; int K, N, kt, nt;
            if (tl < 1024) { src = a.w_in; dst = (bf16_t*)(a.ws + WS_BT1); K = 1024; N = 4096; kt = tl >> 6; nt = tl & 63; }
            else { const int t2 = tl - 1024; src = a.w_out; dst = (bf16_t*)(a.ws + WS_BT2); K = 1536; N = 1024; kt = t2 >> 4; nt = t2 & 15; }
            __syncthreads();
#pragma unroll
            for (int ps = 0; ps < 2; ++ps) { const int rr = (tid >> 4) + ps * 32, c4 = (tid & 15) * 4;
                const f32x4 v = *(const f32x4*)(src + (size_t)(kt * 64 + rr) * N + nt * 64 + c4);
                tile[rr * 65 + c4 + 0] = v[0]; tile[rr * 65 + c4 + 1] = v[1]; tile[rr * 65 + c4 + 2] = v[2]; tile[rr * 65 + c4 + 3] = v[3]; }
            __syncthreads();
            { const int n = tid >> 3, k8 = tid & 7; float f[8];
#pragma unroll
              for (int e = 0; e < 8; ++e) f[e] = tile[(k8 * 8 + e) * 65 + n];
              *(u32x4*)(dst + (size_t)(nt * 64 + n) * K + kt * 64 + k8 * 8) = pack8(f); }
        }
        __syncthreads();
    }
    {
        bf16_t* wg = (bf16_t*)(a.ws + WS_WG);
        for (int i = bx * NTHR + tid; i < 131072; i += G * NTHR) {
            const int e = i & 7, lane = (i >> 3) & 63, ks = (i >> 9) & 1, nb = (i >> 10) & 3, g = (i >> 12) & 1, h = i >> 13;
            const int m = lane & 15, q = lane >> 4;
            const int k = ks * 32 + q * 8 + e, n = (nb >> 1) * 32 + (m >> 2) * 8 + (nb & 1) * 4 + (m & 3);
            const float v = (g ? a.w_ig : a.w_rg)[(size_t)h * 4096 + k * 64 + n];
            wg[i] = (bf16_t)(pg8::cvt_pk_bf16(-1.44269504f * v, 0.f) & 0xffffu);
        }
    }
}

__device__ void p1_norm(const Args& a) {
    const int lane = threadIdx.x & 63, gw = blockIdx.x * NWV + (threadIdx.x >> 6), nw = gridDim.x * NWV;
    const float* ada = (const float*)(a.ws + WS_ADA); bf16_t* hn = (bf16_t*)(a.ws + WS_HN);
    for (int rowa = gw; rowa < MT; rowa += 2 * nw) {
        const int nr = (rowa + nw < MT) ? 2 : 1;
        f32x4 v[2][4]; float ss[2] = {0.f, 0.f};
#pragma unroll
        for (int k = 0; k < 2; ++k) { const int row = (k < nr) ? rowa + k * nw : rowa;
            const float* xr = row < MP ? a.xp + (size_t)row * 1024 : a.xs + (size_t)(row - MP) * 1024;
#pragma unroll
            for (int i = 0; i < 4; ++i) v[k][i] = *(const f32x4*)(xr + (i * 64 + lane) * 4); }
#pragma unroll
        for (int k = 0; k < 2; ++k) {
#pragma unroll
            for (int i = 0; i < 4; ++i) ss[k] += v[k][i][0] * v[k][i][0] + v[k][i][1] * v[k][i][1] + v[k][i][2] * v[k][i][2] + v[k][i][3] * v[k][i][3];
#pragma unroll
            for (int o = 1; o < 64; o <<= 1) ss[k] += __shfl_xor(ss[k], o); }
#pragma unroll
        for (int k = 0; k < 2; ++k) { if (k < nr) { const int row = rowa + k * nw;
            const int b = row < MP ? (row >> 13) : 8 + ((row - MP) >> 4);
            const float rinv = rsqrtf(ss[k] * (1.f / 1024.f) + 1e-6f);
#pragma unroll
            for (int i = 0; i < 4; ++i) { const int c = (i * 64 + lane) * 4;
                const f32x4 g = *(const f32x4*)(a.g_norm + c), sc = *(const f32x4*)(ada + b * 3072 + 1024 + c), sh = *(const f32x4*)(ada + b * 3072 + c);
                const f32x4 o = (v[k][i] * rinv) * g * (sc + 1.f) + sh;
                uint2 w; w.x = pg8::cvt_pk_bf16(o[0], o[1]); w.y = pg8::cvt_pk_bf16(o[2], o[3]);
                *(uint2*)(hn + (size_t)row * 1024 + c) = w; } } }
    }
}

__device__ void p3_mixer_a1(const Args& a, LAS unsigned char* lds) {
    const int lane = threadIdx.x & 63, wv = threadIdx.x >> 6, gw = blockIdx.x * NWV + wv, nw = gridDim.x * NWV;
    const int r = lane & 15, q = lane >> 4;
    LAS float* tbl = (LAS float*)(lds + wv * 2048);
    const bf16_t* proj = (const bf16_t*)(a.ws + WS_PROJ); unsigned* LB = (unsigned*)(a.ws + WS_LB);
    float* agg = (float*)(a.ws + WS_AGG);
    for (int u = gw; u < 2560; u += nw) {
        int head, seq, chunk, L, tstart; size_t rowbase; bool sample, lastchunk;
        if (u < 2048) { head = u & 15; chunk = (u >> 4) & 15; seq = u >> 8; sample = false; rowbase = (size_t)seq * 8192; tstart = chunk * 512; L = 32; lastchunk = (chunk == 15); }
        else { const int v = u - 2048; head = v & 15; seq = v >> 4; chunk = 0; sample = true; rowbase = (size_t)MP + seq * 16; tstart = 0; L = 1; lastchunk = true; }
        __builtin_amdgcn_wave_barrier();
        { const int c = head * 64 + lane;
          tbl[0 * 64 + lane] = a.w_conv_a[0 * 1024 + c]; tbl[1 * 64 + lane] = a.w_conv_a[1 * 1024 + c]; tbl[2 * 64 + lane] = a.w_conv_a[2 * 1024 + c]; tbl[3 * 64 + lane] = a.w_conv_a[3 * 1024 + c];
          tbl[4 * 64 + lane] = a.b_conv_a[c]; tbl[5 * 64 + lane] = -1.44269504f * a.b_rg[c]; tbl[6 * 64 + lane] = -1.44269504f * a.b_ig[c];
          tbl[7 * 64 + lane] = -8.f * 1.44269504f * log1pf(__expf(-a.lam[c])); }
        __builtin_amdgcn_wave_barrier();
        bf16x8 wg[2][4][2];
        { const bf16x8* wgp = (const bf16x8*)(a.ws + WS_WG);
#pragma unroll
          for (int g = 0; g < 2; ++g)
#pragma unroll
            for (int nb = 0; nb < 4; ++nb)
#pragma unroll
              for (int ks = 0; ks < 2; ++ks) wg[g][nb][ks] = wgp[((((head * 2 + g) * 4 + nb) * 2 + ks) * 64) + lane]; }
        float hrun[16], prun[16];
#pragma unroll
        for (int i = 0; i < 16; ++i) { hrun[i] = 0.f; prun[i] = 1.f; }
        const int cb0 = head * 64 + q * 8;
        const int t0 = tstart + r * L;
        const bf16_t* prow = proj + (rowbase + t0) * 4096 + cb0;
        u32x4 W[3][2], Xn[2], Xn2[2];
#pragma unroll
        for (int kk = 0; kk < 3; ++kk)
#pragma unroll
            for (int ks = 0; ks < 2; ++ks) {
                const int trel = t0 - 3 + kk;
                u32x4 v = (u32x4){0u, 0u, 0u, 0u};
                if (trel >= 0) v = *(const u32x4*)(prow + (ptrdiff_t)(kk - 3) * 4096 + ks * 32);
                else if (sample) { const float* cpn = a.cache_a + ((size_t)seq * 3 + (3 + trel)) * 1024 + cb0 + ks * 32; float f[8];
#pragma unroll
                    for (int e = 0; e < 8; ++e) f[e] = cpn[e];
                    v = pack8(f); }
                W[kk][ks] = v; }
#pragma unroll
        for (int ks = 0; ks < 2; ++ks) { Xn[ks] = *(const u32x4*)(prow + ks * 32); Xn2[ks] = *(const u32x4*)(prow + (size_t)(L > 1 ? 1 : 0) * 4096 + ks * 32); }
        for (int blk = 0; blk < L; ++blk) {
            const size_t row = rowbase + t0 + blk;
            u32x4 Xc[2];
#pragma unroll
            for (int ks = 0; ks < 2; ++ks) { Xc[ks] = Xn[ks]; Xn[ks] = Xn2[ks]; }
            { const int nb2 = (blk + 2 < L) ? blk + 2 : L - 1;
#pragma unroll
              for (int ks = 0; ks < 2; ++ks) Xn2[ks] = *(const u32x4*)(prow + (size_t)nb2 * 4096 + ks * 32); }
            float xc[16]; bf16x8 af[2];
#pragma unroll
            for (int ks = 0; ks < 2; ++ks) {
                const int cl0 = ks * 32 + q * 8;
                float acc8[8];
                { const f32x4 b0 = *(const LAS f32x4*)(tbl + 4 * 64 + cl0), b1 = *(const LAS f32x4*)(tbl + 4 * 64 + cl0 + 4);
                  acc8[0] = b0[0]; acc8[1] = b0[1]; acc8[2] = b0[2]; acc8[3] = b0[3]; acc8[4] = b1[0]; acc8[5] = b1[1]; acc8[6] = b1[2]; acc8[7] = b1[3]; }
#pragma unroll
                for (int kk = 0; kk < 4; ++kk) {
                    float X[8]; unpack8(kk < 3 ? W[kk][ks] : Xc[ks], X);
                    const f32x4 w0 = *(const LAS f32x4*)(tbl + kk * 64 + cl0), w1 = *(const LAS f32x4*)(tbl + kk * 64 + cl0 + 4);
                    acc8[0] += w0[0] * X[0]; acc8[1] += w0[1] * X[1]; acc8[2] += w0[2] * X[2]; acc8[3] += w0[3] * X[3];
                    acc8[4] += w1[0] * X[4]; acc8[5] += w1[1] * X[5]; acc8[6] += w1[2] * X[6]; acc8[7] += w1[3] * X[7];
                }
#pragma unroll
                for (int e = 0; e < 8; ++e) xc[ks * 8 + e] = acc8[e];
                const u32x4 pk = pack8(acc8);
                af[ks] = __builtin_bit_cast(bf16x8, pk);
            }
            if (lastchunk && blk == L - 1 && r == 15) {
#pragma unroll
                for (int kk = 1; kk < 4; ++kk)
#pragma unroll
                    for (int ks = 0; ks < 2; ++ks) { float X[8]; unpack8(kk < 3 ? W[kk][ks] : Xc[ks], X);
                        float* o = a.out + (sample ? O_CAS : O_CAP) + ((size_t)seq * 3 + (kk - 1)) * 1024 + cb0 + ks * 32;
                        *(f32x4*)o = (f32x4){X[0], X[1], X[2], X[3]}; *(f32x4*)(o + 4) = (f32x4){X[4], X[5], X[6], X[7]}; }
            }
#pragma unroll
            for (int nb = 0; nb < 4; ++nb) {
                const int ks = nb >> 1, e0 = (nb & 1) * 4, cl0 = ks * 32 + q * 8 + e0, i0 = ks * 8 + e0;
                const f32x4 brg = *(const LAS f32x4*)(tbl + 5 * 64 + cl0), big = *(const LAS f32x4*)(tbl + 6 * 64 + cl0), nsp = *(const LAS f32x4*)(tbl + 7 * 64 + cl0);
                f32x4 R = __builtin_amdgcn_mfma_f32_16x16x32_bf16(wg[0][nb][0], af[0], brg, 0, 0, 0);
                R = __builtin_amdgcn_mfma_f32_16x16x32_bf16(wg[0][nb][1], af[1], R, 0, 0, 0);
                f32x4 I = __builtin_amdgcn_mfma_f32_16x16x32_bf16(wg[1][nb][0], af[0], big, 0, 0, 0);
                I = __builtin_amdgcn_mfma_f32_16x16x32_bf16(wg[1][nb][1], af[1], I, 0, 0, 0);
                u32x4 lbw;
#pragma unroll
                for (int j = 0; j < 4; ++j) {
                    const float rg = __builtin_amdgcn_rcpf(1.f + __builtin_amdgcn_exp2f(R[j]));
                    const float ig = __builtin_amdgcn_rcpf(1.f + __builtin_amdgcn_exp2f(I[j]));
                    const float la2 = nsp[j] * rg;
                    const float av = __builtin_amdgcn_exp2f(la2);
                    const float bb = __builtin_amdgcn_sqrtf(__builtin_fmaf(-av, av, 1.f)) * (ig * xc[i0 + j]);
                    lbw[j] = pg8::cvt_pk_bf16(la2, bb);
                    hrun[i0 + j] = __builtin_fmaf(av, hrun[i0 + j], bb);
                    prun[i0 + j] *= av;
                }
                *(u32x4*)(LB + row * 1024 + head * 64 + cl0) = lbw;
            }
#pragma unroll
            for (int ks = 0; ks < 2; ++ks) { W[0][ks] = W[1][ks]; W[1][ks] = W[2][ks]; W[2][ks] = Xc[ks]; }
        }
        if (!sample) {
#pragma unroll
            for (int g4 = 0; g4 < 4; ++g4) { const int i0 = g4 * 4;
                scan4(prun[i0], prun[i0 + 1], prun[i0 + 2], prun[i0 + 3], hrun[i0], hrun[i0 + 1], hrun[i0 + 2], hrun[i0 + 3], 0.f, 0.f, 0.f, 0.f); }
            if (r == 15) {
#pragma unroll
                for (int i = 0; i < 16; ++i) *(float2*)(agg + ((size_t)(seq * 16 + chunk) * 1024 + head * 64 + (i >> 3) * 32 + q * 8 + (i & 7)) * 2) = make_float2(prun[i], hrun[i]);
            }
        }
    }
}

struct A2Regs { u32x4 lb[4]; u32x4 g[2]; };
__device__ __forceinline__ void a2_load(A2Regs& R, const unsigned* LB, const bf16_t* proj, size_t row, int cb) {
#pragma unroll
    for (int ks = 0; ks < 2; ++ks) { const unsigned* lp = LB + row * 1024 + cb + ks * 32; R.lb[ks * 2] = *(const u32x4*)lp; R.lb[ks * 2 + 1] = *(const u32x4*)(lp + 4);
        R.g[ks] = *(const u32x4*)(proj + row * 4096 + 1024 + cb + ks * 32); }
}
__device__ __forceinline__ void a2_block(const A2Regs& R, float (&hprev)[16], bf16_t* ymix, size_t row, int cb, int r) {
#pragma unroll
    for (int ks = 0; ks < 2; ++ks) {
        float G[8]; unpack8(R.g[ks], G);
        float y[8];
#pragma unroll
        for (int hh = 0; hh < 2; ++hh) {
            const u32x4 w = R.lb[ks * 2 + hh]; const int i0 = ks * 8 + hh * 4;
            float av[4], bb[4], hm[4];
#pragma unroll
            for (int j = 0; j < 4; ++j) { av[j] = __builtin_amdgcn_exp2f(bf_lo(w[j])); bb[j] = bf_hi(w[j]); hm[j] = (r == 15) ? hprev[i0 + j] : 0.f; }
            scan4(av[0], av[1], av[2], av[3], bb[0], bb[1], bb[2], bb[3], hm[0], hm[1], hm[2], hm[3]);
#pragma unroll
            for (int j = 0; j < 4; ++j) { hprev[i0 + j] = bb[j]; const float g = G[hh * 4 + j]; y[hh * 4 + j] = bb[j] * (g * sigmoidf_(g)); }
        }
        *(u32x4*)(ymix + row * 1536 + cb + ks * 32) = pack8(y);
    }
}
__device__ void p4_mixer_a2(const Args& a) {
    const int lane = threadIdx.x & 63, wv = threadIdx.x >> 6, gw = blockIdx.x * NWV + wv, nw = gridDim.x * NWV;
    const int r = lane & 15, q = lane >> 4;
    const bf16_t* proj = (const bf16_t*)(a.ws + WS_PROJ); bf16_t* ymix = (bf16_t*)(a.ws + WS_YMIX); const unsigned* LB = (const unsigned*)(a.ws + WS_LB);
    const float* agg = (const float*)(a.ws + WS_AGG);
    for (int u = gw; u < 2560; u += nw) {
        int head, seq, chunk, nblk, tstart; size_t rowbase; bool sample, lastchunk;
        if (u < 2048) { head = u & 15; chunk = (u >> 4) & 15; seq = u >> 8; sample = false; rowbase = (size_t)seq * 8192; tstart = chunk * 512; nblk = 32; lastchunk = (chunk == 15); }
        else { const int v = u - 2048; head = v & 15; seq = v >> 4; chunk = 0; sample = true; rowbase = (size_t)MP + seq * 16; tstart = 0; nblk = 1; lastchunk = true; }
        const int cb = head * 64 + q * 8;
        float hprev[16];
#pragma unroll
        for (int i = 0; i < 16; ++i) hprev[i] = 0.f;
        if (sample) {
#pragma unroll
            for (int i = 0; i < 16; ++i) hprev[i] = a.state[(size_t)seq * 1024 + cb + (i >> 3) * 32 + (i & 7)];
        } else {
            for (int jj = 0; jj < chunk; ++jj) {
#pragma unroll
                for (int i = 0; i < 16; ++i) { const float2 ph = *(const float2*)(agg + ((size_t)(seq * 16 + jj) * 1024 + cb + (i >> 3) * 32 + (i & 7)) * 2);
                    hprev[i] = ph.x * hprev[i] + ph.y; }
            }
        }
        const size_t row0 = rowbase + tstart + r;
        if (nblk == 1) { A2Regs c0; a2_load(c0, LB, proj, row0, cb); a2_block(c0, hprev, ymix, row0, cb, r); }
        else {
            A2Regs c0, c1, n0, n1;
            a2_load(c0, LB, proj, row0, cb); a2_load(c1, LB, proj, row0 + 16, cb);
            for (int blk = 0; blk < nblk; blk += 2) {
                const size_t row = row0 + (size_t)blk * 16;
                const size_t rown = (blk + 2 < nblk) ? row + 32 : row;
                a2_load(n0, LB, proj, rown, cb); a2_load(n1, LB, proj, rown + 16, cb);
                a2_block(c0, hprev, ymix, row, cb, r); a2_block(c1, hprev, ymix, row + 16, cb, r);
                c0 = n0; c1 = n1;
            }
        }
        if (lastchunk && r == 15) {
#pragma unroll
            for (int ks = 0; ks < 2; ++ks) { float* o = a.out + (sample ? O_LRS : O_LRP) + (size_t)seq * 1024 + cb + ks * 32;
                *(f32x4*)o = (f32x4){hprev[ks * 8 + 0], hprev[ks * 8 + 1], hprev[ks * 8 + 2], hprev[ks * 8 + 3]};
                *(f32x4*)(o + 4) = (f32x4){hprev[ks * 8 + 4], hprev[ks * 8 + 5], hprev[ks * 8 + 6], hprev[ks * 8 + 7]}; }
        }
    }
}

__device__ void p3_mixer_b(const Args& a) {
    const bf16_t* proj = (const bf16_t*)(a.ws + WS_PROJ); bf16_t* ymix = (bf16_t*)(a.ws + WS_YMIX);
    for (int it = blockIdx.x * NTHR + threadIdx.x; it < (MT / 16) * 64; it += gridDim.x * NTHR) {
        const int rb = it >> 6, cg = it & 63, c0 = cg * 8;
        const bool sample = rb >= 4096; const int seq = sample ? rb - 4096 : rb >> 9, t0 = sample ? 0 : (rb & 511) * 16;
        const size_t rowbase = sample ? (size_t)MP + seq * 16 : (size_t)seq * 8192;
        float w[3][8];
#pragma unroll
        for (int k = 0; k < 3; ++k) { const f32x4 w0 = *(const f32x4*)(a.w_conv_b + k * 512 + c0), w1 = *(const f32x4*)(a.w_conv_b + k * 512 + c0 + 4);
            w[k][0] = w0[0]; w[k][1] = w0[1]; w[k][2] = w0[2]; w[k][3] = w0[3]; w[k][4] = w1[0]; w[k][5] = w1[1]; w[k][6] = w1[2]; w[k][7] = w1[3]; }
        float vm2[8], vm1[8];
        if (t0 > 0) {
            float xa[8], ca[8];
            unpack8(*(const u32x4*)(proj + (rowbase + t0 - 2) * 4096 + 2048 + c0), xa); unpack8(*(const u32x4*)(proj + (rowbase + t0 - 2) * 4096 + 3072 + c0), ca);
#pragma unroll
            for (int e = 0; e < 8; ++e) vm2[e] = xa[e] * ca[e];
            unpack8(*(const u32x4*)(proj + (rowbase + t0 - 1) * 4096 + 2048 + c0), xa); unpack8(*(const u32x4*)(proj + (rowbase + t0 - 1) * 4096 + 3072 + c0), ca);
#pragma unroll
            for (int e = 0; e < 8; ++e) vm1[e] = xa[e] * ca[e];
        } else if (sample) {
#pragma unroll
            for (int e = 0; e < 8; ++e) { vm2[e] = a.cache_b[((size_t)seq * 2 + 0) * 512 + c0 + e]; vm1[e] = a.cache_b[((size_t)seq * 2 + 1) * 512 + c0 + e]; }
        } else {
#pragma unroll
            for (int e = 0; e < 8; ++e) { vm2[e] = 0.f; vm1[e] = 0.f; }
        }
        for (int tt = 0; tt < 16; ++tt) {
            const size_t row = rowbase + t0 + tt;
            float xb[8], cgt[8], bg[8], gb[8];
            unpack8(*(const u32x4*)(proj + row * 4096 + 2048 + c0), xb); unpack8(*(const u32x4*)(proj + row * 4096 + 2560 + c0), bg);
            unpack8(*(const u32x4*)(proj + row * 4096 + 3072 + c0), cgt); unpack8(*(const u32x4*)(proj + row * 4096 + 3584 + c0), gb);
            float y[8];
#pragma unroll
            for (int e = 0; e < 8; ++e) { const float v = cgt[e] * xb[e]; const float uu = w[0][e] * vm2[e] + w[1][e] * vm1[e] + w[2][e] * v;
                y[e] = bg[e] * uu * (gb[e] * sigmoidf_(gb[e])); vm2[e] = vm1[e]; vm1[e] = v; }
            *(u32x4*)(ymix + row * 1536 + 1024 + c0) = pack8(y);
        }
        const bool last = sample ? true : ((rb & 511) == 511);
        if (last) { float* o = a.out + (sample ? O_CBS : O_CBP) + (size_t)seq * 2 * 512 + c0;
#pragma unroll
            for (int e = 0; e < 8; ++e) { o[e] = vm2[e]; o[512 + e] = vm1[e]; } }
    }
}

__device__ void p5_final(const Args& a) {
    const int lane = threadIdx.x & 63, gw = blockIdx.x * NWV + (threadIdx.x >> 6), nw = gridDim.x * NWV;
    const float* rss = (const float*)(a.ws + WS_RSS);
    for (int row = gw; row < MT; row += nw) {
        float* yr = a.out + (size_t)row * 1024;
        float ss = lane < 16 ? rss[(size_t)row * 16 + lane] : 0.f;
#pragma unroll
        for (int o = 1; o < 16; o <<= 1) ss += __shfl_xor(ss, o);
        ss = __shfl(ss, 0);
        const float rinv = rsqrtf(ss * (1.f / 1024.f) + 1e-6f);
#pragma unroll
        for (int i = 0; i < 4; ++i) { const int c = (i * 64 + lane) * 4;
            const f32x4 v = *(const f32x4*)(yr + c), g = *(const f32x4*)(a.g_final + c);
            *(f32x4*)(yr + c) = (v * rinv) * g; }
    }
}


__device__ void p6_final(const Args& a) {
    const int lane = threadIdx.x & 63, gw = blockIdx.x * NWV + (threadIdx.x >> 6), nw = gridDim.x * NWV;
    const float* ada = (const float*)(a.ws + WS_ADA); const bf16_t* om = (const bf16_t*)(a.ws + WS_OM);
    for (int rowa = gw; rowa < MT; rowa += 2 * nw) {
        const int nr = (rowa + nw < MT) ? 2 : 1;
        f32x4 v[2][4]; uint2 w[2][4];
#pragma unroll
        for (int k = 0; k < 2; ++k) { const int row = (k < nr) ? rowa + k * nw : rowa;
            const float* xr = row < MP ? a.xp + (size_t)row * 1024 : a.xs + (size_t)(row - MP) * 1024;
#pragma unroll
            for (int i = 0; i < 4; ++i) { v[k][i] = *(const f32x4*)(xr + (i * 64 + lane) * 4); w[k][i] = *(const uint2*)(om + (size_t)row * 1024 + (i * 64 + lane) * 4); } }
        float ss[2] = {0.f, 0.f};
#pragma unroll
        for (int k = 0; k < 2; ++k) { const int row = (k < nr) ? rowa + k * nw : rowa;
            const int b = row < MP ? (row >> 13) : 8 + ((row - MP) >> 4);
#pragma unroll
            for (int i = 0; i < 4; ++i) { const f32x4 g = *(const f32x4*)(ada + (size_t)b * 3072 + 2048 + (i * 64 + lane) * 4);
                const f32x4 o = (f32x4){bf_lo(w[k][i].x), bf_hi(w[k][i].x), bf_lo(w[k][i].y), bf_hi(w[k][i].y)};
                v[k][i] = v[k][i] + g * o;
                ss[k] += v[k][i][0] * v[k][i][0] + v[k][i][1] * v[k][i][1] + v[k][i][2] * v[k][i][2] + v[k][i][3] * v[k][i][3]; }
#pragma unroll
            for (int o = 1; o < 64; o <<= 1) ss[k] += __shfl_xor(ss[k], o); }
#pragma unroll
        for (int k = 0; k < 2; ++k) { if (k < nr) { const int row = rowa + k * nw;
            const float rinv = rsqrtf(ss[k] * (1.f / 1024.f) + 1e-6f);
            float* yr = a.out + (size_t)row * 1024;
#pragma unroll
            for (int i = 0; i < 4; ++i) { const int c = (i * 64 + lane) * 4; const f32x4 g = *(const f32x4*)(a.g_final + c);
                *(f32x4*)(yr + c) = (v[k][i] * rinv) * g; } } }
    }
}

__global__ void __launch_bounds__(NTHR, 2) mega_fwd(Args a) {
    extern __shared__ __attribute__((aligned(16))) unsigned char lds_raw[];
    LAS unsigned char* lds = (LAS unsigned char*)lds_raw;
    cg::grid_group grid = cg::this_grid();
    const int lo = a.ph_lo, hi = a.ph_hi;
    if (hi > 1000) grid.sync();
    if (threadIdx.x < 4) ((LAS unsigned*)(lds + pg8::STAGE_BYTES))[threadIdx.x] = 0u;
    __syncthreads();
    XcdBarrier bar = xcd_barrier_post((unsigned*)(a.ws + WS_BAR), (volatile LAS unsigned*)(lds + pg8::STAGE_BYTES));
#define IN(k) (lo <= (k) && (k) < hi)
#define SEAM(k) do { if (IN(k) && IN((k) + 1)) xcd_barrier(bar); } while (0)
    if (IN(0)) p0_prologue(a, lds);
    SEAM(0);
    if (IN(1)) p1_norm(a);
    SEAM(1);
    if (IN(2)) { pg8::Gemm g{(const bf16_t*)(a.ws + WS_HN), (const bf16_t*)(a.ws + WS_BT1), MT, 4096, 1024}; pg8::StaticOrder S; S.init(MT, 4096, (int)gridDim.x, (int)blockIdx.x);
        pg8::EpiBf16 E{(bf16_t*)(a.ws + WS_PROJ), 4096};
        pg8::gemm_phase<pg8::EpiBf16, pg8::StaticOrder, false>(lds, g, S, E, nullptr); }
    SEAM(2);
    if (IN(3)) p3_mixer_a1(a, lds);
    SEAM(3);
    if (IN(4)) { p4_mixer_a2(a); p3_mixer_b(a); }
    SEAM(4);
    if (IN(5)) { pg8::Gemm g{(const bf16_t*)(a.ws + WS_YMIX), (const bf16_t*)(a.ws + WS_BT2), MT, 1024, 1536}; pg8::StaticOrder S; S.init(MT, 1024, (int)gridDim.x, (int)blockIdx.x);
        pg8::EpiBf16 E{(bf16_t*)(a.ws + WS_OM), 1024};
        pg8::gemm_phase<pg8::EpiBf16, pg8::StaticOrder, false>(lds, g, S, E, nullptr); }
    SEAM(5);
    if (IN(6)) p6_final(a);
#undef IN
#undef SEAM
}

#ifndef N_LAUNCHES
#define N_LAUNCHES 1
#endif
constexpr int NPH = 7, LDS_BYTES = pg8::STAGE_BYTES + 16;

extern "C" void kernel_launch(void* const* d_in, const int* in_sizes, int n_in, void* d_out, int out_size, void* d_ws, size_t ws_size, hipStream_t stream) {
    static int grid = 0;
    if (grid == 0) {
        if (n_in != 21 || (size_t)out_size != O_END || ws_size < WS_END) { fprintf(stderr, "kernel_launch: unexpected shapes (n_in %d out %d ws %zu need %zu)\n", n_in, out_size, ws_size, (size_t)WS_END); grid = -1; return; }
        int dev = 0, cus = 0, per_cu = 0;
        hipGetDevice(&dev); hipDeviceGetAttribute(&cus, hipDeviceAttributeMultiprocessorCount, dev);
        if (hipFuncSetAttribute((const void*)mega_fwd, hipFuncAttributeMaxDynamicSharedMemorySize, LDS_BYTES) != hipSuccess) { fprintf(stderr, "kernel_launch: hipFuncSetAttribute failed\n"); grid = -1; return; }
        if (hipOccupancyMaxActiveBlocksPerMultiprocessor(&per_cu, (const void*)mega_fwd, NTHR, LDS_BYTES) != hipSuccess || per_cu < 1) { fprintf(stderr, "kernel_launch: occupancy query says %d\n", per_cu); per_cu = 1; }
        (void)hipGetLastError();
        grid = cus * 1;
    }
    if (grid < 0) return;
    if (hipMemsetAsync((char*)d_ws + WS_BAR, 0, XCD_BAR_WORDS * 4, stream) != hipSuccess) { fprintf(stderr, "kernel_launch: memset failed\n"); return; }
    Args a{};
    const float** ip = (const float**)&a;
    for (int i = 0; i < 21; ++i) ip[i] = (const float*)d_in[i];
    a.out = (float*)d_out; a.ws = (unsigned char*)d_ws;
#if N_LAUNCHES == 1
    a.ph_lo = 0; a.ph_hi = NPH;
    void* args[] = {&a};
    hipError_t e = hipLaunchCooperativeKernel((const void*)mega_fwd, dim3(grid), dim3(NTHR), args, LDS_BYTES, stream);
    if (e != hipSuccess) fprintf(stderr, "cooperative launch failed: %s (grid %d)\n", hipGetErrorString(e), grid);
#else
    for (int ph = 0; ph < NPH; ++ph) { a.ph_lo = ph; a.ph_hi = ph + 1; hipLaunchKernelGGL(mega_fwd, dim3(grid), dim3(NTHR), LDS_BYTES, stream, a); }
#endif
}
```

```cpp
#include <hip/hip_cooperative_groups.h>
#include <cstdio>
#include <cstdint>
namespace cg = cooperative_groups;
#include <hip/hip_runtime.h>
namespace pg8 {
#define PG8_LAS __attribute__((address_space(3)))
typedef unsigned short bf16_t;
typedef short bf16x8 __attribute__((ext_vector_type(8)));
typedef float f32x4 __attribute__((ext_vector_type(4)));
typedef unsigned u32x4 __attribute__((ext_vector_type(4)));
constexpr int BM = 256, BK = 64, HALF = 128, HTB = HALF * BK * 2  , STAGE_BYTES = 8 * HTB, NXCD = 8, WGM = 8;

__host__ __device__ __forceinline__ int lds_byte(int r, int c) { const int st = (r >> 4) * 2 + (c >> 5), rr = r & 15, cc = c & 31, ob = rr * 64 + cc * 2; return st * 1024 + (ob ^ (((ob >> 9) & 1) << 5)); }
__host__ __device__ __forceinline__ void stage_rc(int b, int& R, int& C) { const int st = b / 1024, sb = b % 1024, swz = sb ^ (((sb >> 9) & 1) << 5); R = (st >> 1) * 16 + swz / 64; C = (st & 1) * 32 + (swz % 64) / 2; }
__host__ __device__ __forceinline__ int perm32(int rho) { const int n = rho >> 4, i = rho & 15; return 8 * (i >> 2) + 4 * n + (i & 3); }

struct Unit { int pm, pn; };
struct Gemm { const bf16_t* A; const bf16_t* Bt; int M, N, K; };

struct StaticOrder {
    int nM, nN, nwg, G, c;
    __host__ __device__ void init(int M, int N, int G_, int c_) { nM = M / BM; nN = N / BM; nwg = nM * nN; G = G_; c = c_; }
    __host__ __device__ bool next(int i, Unit& u) const {
        const long L = (long)i * G + c; if (L >= nwg) return false;
        int wgid = (int)L; { const int q = nwg / NXCD, r = nwg % NXCD, xcd = wgid % NXCD, off = wgid / NXCD; wgid = (xcd < r ? xcd * (q + 1) : r * (q + 1) + (xcd - r) * q) + off; }
        const int nig = WGM * nN, gid = wgid / nig, fm = gid * WGM, gsz = (nM - fm) < WGM ? (nM - fm) : WGM;
        u.pm = fm + ((wgid % nig) % gsz); u.pn = (wgid % nig) / gsz; return true;
    }
    __device__ __forceinline__ void a_ready(const Unit&) const {}
    __device__ __forceinline__ void done(const Unit&) const {}
};
__device__ __forceinline__ unsigned cvt_pk_bf16(float lo, float hi) { unsigned r; asm volatile("v_cvt_pk_bf16_f32 %0, %1, %2" : "=v"(r) : "v"(lo), "v"(hi)); return r; }
struct EpiBf16 {
    static constexpr bool PERM = true, AFTER_DRAIN = false;
    bf16_t* O; int ldc;
    __device__ __forceinline__ void operator()(const f32x4 (&acc)[2][2][4][2], const Unit& u, int wr, int wc, int fr, int fq) const {
        const int row0 = u.pm * BM + wr * 64 + fr; const int col0 = u.pn * BM + wc * 32 + 8 * fq;
#pragma unroll
        for (int ai = 0; ai < 2; ++ai)
#pragma unroll
            for (int m = 0; m < 4; ++m) { bf16_t* rowp = O + (size_t)(row0 + ai * HALF + m * 16) * ldc + col0;
#pragma unroll
                for (int bj = 0; bj < 2; ++bj) { const f32x4 v0 = acc[ai][bj][m][0], v1 = acc[ai][bj][m][1];
                    u32x4 w; w.x = cvt_pk_bf16(v0[0], v0[1]); w.y = cvt_pk_bf16(v0[2], v0[3]); w.z = cvt_pk_bf16(v1[0], v1[1]); w.w = cvt_pk_bf16(v1[2], v1[3]);
                    *(u32x4*)(rowp + bj * HALF) = w; } }
    }
};
struct EpiRes {
    static constexpr bool PERM = false, AFTER_DRAIN = false;
    const float* xp; const float* xs; const float* ada; float* out; float* rss;
    __device__ __forceinline__ void operator()(const f32x4 (&acc)[2][2][4][2], const Unit& u, int wr, int wc, int fr, int fq) const {
        const int col0 = u.pn * BM + wc * 32 + 4 * fq;
#pragma unroll
        for (int ai = 0; ai < 2; ++ai)
#pragma unroll
            for (int m = 0; m < 4; ++m) {
                const int row = u.pm * BM + ai * HALF + wr * 64 + m * 16 + fr;
                const float* xr = row < 65536 ? xp + (size_t)row * 1024 : xs + (size_t)(row - 65536) * 1024;
                const int b = row < 65536 ? (row >> 13) : 8 + ((row - 65536) >> 4);
                const float* gr = ada + (size_t)b * 3072 + 2048;
                float* orow = out + (size_t)row * 1024;
                float s = 0.f;
#pragma unroll
                for (int bj = 0; bj < 2; ++bj)
#pragma unroll
                    for (int n = 0; n < 2; ++n) { const int c = col0 + bj * HALF + n * 16;
                        const f32x4 xv = *(const f32x4*)(xr + c), gv = *(const f32x4*)(gr + c);
                        const f32x4 o = xv + gv * acc[ai][bj][m][n];
                        *(f32x4*)(orow + c) = o; s += o[0] * o[0] + o[1] * o[1] + o[2] * o[2] + o[3] * o[3]; }
                s += __shfl_xor(s, 16); s += __shfl_xor(s, 32);
                if (fq == 0) rss[(size_t)row * 16 + u.pn * 4 + wc] = s;
            }
    }
};

struct EpiResNorm {
    static constexpr bool PERM = false, AFTER_DRAIN = false;
    const float* xp; const float* xs; const float* ada; const float* gfin; float* out; float* xbuf; unsigned* cnt;
    __device__ __forceinline__ void operator()(f32x4 (&acc)[2][2][4][2], const Unit& u, int wr, int wc, int fr, int fq) const {
        const int col0 = u.pn * BM + wc * 32 + 4 * fq;
#pragma unroll
        for (int ai = 0; ai < 2; ++ai)
#pragma unroll
            for (int m = 0; m < 4; ++m) {
                const int row = u.pm * BM + ai * HALF + wr * 64 + m * 16 + fr;
                const float* xr = row < 65536 ? xp + (size_t)row * 1024 : xs + (size_t)(row - 65536) * 1024;
                const int b = row < 65536 ? (row >> 13) : 8 + ((row - 65536) >> 4);
                const float* gr = ada + (size_t)b * 3072 + 2048;
                float s = 0.f;
#pragma unroll
                for (int bj = 0; bj < 2; ++bj)
#pragma unroll
                    for (int n = 0; n < 2; ++n) { const int c = col0 + bj * HALF + n * 16;
                        const f32x4 xv = *(const f32x4*)(xr + c), gv = *(const f32x4*)(gr + c);
                        const f32x4 o = xv + gv * acc[ai][bj][m][n];
                        acc[ai][bj][m][n] = o; s += o[0] * o[0] + o[1] * o[1] + o[2] * o[2] + o[3] * o[3]; }
                s += __shfl_xor(s, 16); s += __shfl_xor(s, 32);
                if (fq == 0) __hip_atomic_store(xbuf + (size_t)row * 16 + u.pn * 4 + wc, s, __ATOMIC_RELAXED, __HIP_MEMORY_SCOPE_AGENT);
            }
        asm volatile("s_waitcnt vmcnt(0)" ::: "memory");
        unsigned* c = cnt + (size_t)(u.pm * 2 + wr) * 64;
        if (fr == 0 && fq == 0) __hip_atomic_fetch_add(c, 1u, __ATOMIC_RELAXED, __HIP_MEMORY_SCOPE_AGENT);
        { const unsigned long long t0 = __builtin_amdgcn_s_memrealtime();
          while ((unsigned)__builtin_amdgcn_readfirstlane(__hip_atomic_load(c, __ATOMIC_RELAXED, __HIP_MEMORY_SCOPE_AGENT)) < 16u) {
              if (__builtin_amdgcn_s_memrealtime() - t0 > 4000000ull) break;
              __builtin_amdgcn_s_sleep(2); } }
        asm volatile("" ::: "memory");
#pragma unroll
        for (int ai = 0; ai < 2; ++ai)
#pragma unroll
            for (int m = 0; m < 4; ++m) {
                const int row = u.pm * BM + ai * HALF + wr * 64 + m * 16 + fr;
                const float* xb = xbuf + (size_t)row * 16 + fq * 4;
                float t = (__hip_atomic_load(xb, __ATOMIC_RELAXED, __HIP_MEMORY_SCOPE_AGENT) + __hip_atomic_load(xb + 1, __ATOMIC_RELAXED, __HIP_MEMORY_SCOPE_AGENT))
                        + (__hip_atomic_load(xb + 2, __ATOMIC_RELAXED, __HIP_MEMORY_SCOPE_AGENT) + __hip_atomic_load(xb + 3, __ATOMIC_RELAXED, __HIP_MEMORY_SCOPE_AGENT));
                t += __shfl_xor(t, 16); t += __shfl_xor(t, 32);
                const float rinv = rsqrtf(t * (1.f / 1024.f) + 1e-6f);
                float* orow = out + (size_t)row * 1024;
#pragma unroll
                for (int bj = 0; bj < 2; ++bj)
#pragma unroll
                    for (int n = 0; n < 2; ++n) { const int cc = col0 + bj * HALF + n * 16;
                        const f32x4 g = *(const f32x4*)(gfin + cc);
                        *(f32x4*)(orow + cc) = (acc[ai][bj][m][n] * rinv) * g; }
            }
    }
};
struct RowOrder {
    int G, c, nM;
    __host__ __device__ void init(int M, int G_, int c_) { nM = M / BM; G = G_; c = c_; }
    __host__ __device__ bool next(int i, Unit& u) const {
        int pslot, pn;
        if ((G & 31) == 0) { const int xcd = c & 7, slot = c >> 3; pslot = xcd * (G >> 5) + (slot >> 2); pn = slot & 3; }
        else { pslot = c >> 2; pn = c & 3; if (c >= (G & ~3)) return false; }
        const int pm = i * (G >> 2) + pslot; if (pm >= nM) return false;
        u.pm = pm; u.pn = pn; return true;
    }
    __device__ __forceinline__ void a_ready(const Unit&) const {}
    __device__ __forceinline__ void done(const Unit&) const {}
};

template <class Epi, class Sched, bool STAMP = false, bool ALIGN_EPI = true>
__device__ __forceinline__ void gemm_phase(PG8_LAS unsigned char* lds, const Gemm g, const Sched& S, const Epi& E, unsigned long long* stamps) {
    const int tid = threadIdx.x, wid = __builtin_amdgcn_readfirstlane(tid >> 6), lane = tid & 63, wr = wid >> 2, wc = wid & 3, fr = lane & 15, fq = lane >> 4;
    const int K = g.K, nt = K / BK;
    int ts_lo = 0, ts_hi = 0, nts = 0; const unsigned long long rt_entry = STAMP ? (unsigned long long)wall_clock64() : 0ull;
#define PG8_STAMP() do { if (STAMP && wid == 0 && nts < 64) { const unsigned long long _c = (unsigned long long)clock64(); \
        ts_lo = (lane == nts) ? (int)(unsigned)_c : ts_lo; ts_hi = (lane == nts) ? (int)(unsigned)(_c >> 32) : ts_hi; ++nts; } } while (0)
    PG8_STAMP();
    unsigned voffA[2], voffB[2];
#pragma unroll
    for (int i = 0; i < 2; ++i) { int R, C; stage_rc(tid * 16 + i * 8192, R, C); const int Rb = Epi::PERM ? ((R & ~31) + perm32(R & 31)) : R;
        voffA[i] = (unsigned)(R * K + C) * 2u; voffB[i] = (unsigned)(Rb * K + C) * 2u; }
    const size_t kstep = (size_t)(BK * 2);
    const size_t hstep = (size_t)HALF * K * 2;
    const size_t tstep = 2 * hstep;
    const unsigned ldsw = (unsigned)wid * 1024u;
    const int aoff = lds_byte(wr * 64 + fr, fq * 8), boff = lds_byte(wc * 32 + fr, fq * 8);
#define PG8_SA(b, h) (((b) * 2 + (h)) * HTB)
#define PG8_SB(b, h) ((4 + (b) * 2 + (h)) * HTB)
#define PG8_STAGE(bufoff, gbase, voff) do { _Pragma("unroll") for (int _i = 0; _i < 2; ++_i) \
        __builtin_amdgcn_global_load_lds((const unsigned*)((const char*)(gbase) + (voff)[_i]), (PG8_LAS unsigned*)(lds + (bufoff) + ldsw + _i * 8192), 16, 0, 0); } while (0)
#define PG8_LDA(dst, b, h) do { _Pragma("unroll") for (int m = 0; m < 4; ++m) _Pragma("unroll") for (int k = 0; k < 2; ++k) dst[m][k] = *(const PG8_LAS bf16x8*)(lds + PG8_SA(b, h) + aoff + m * 2048 + k * 1024); } while (0)
#define PG8_LDB(dst, b, h) do { _Pragma("unroll") for (int n = 0; n < 2; ++n) _Pragma("unroll") for (int k = 0; k < 2; ++k) dst[n][k] = *(const PG8_LAS bf16x8*)(lds + PG8_SB(b, h) + boff + n * 2048 + k * 1024); } while (0)
#define PG8_MMA(ai, bj, At, Bt) do { __builtin_amdgcn_s_setprio(1); _Pragma("unroll") for (int m = 0; m < 4; ++m) _Pragma("unroll") for (int n = 0; n < 2; ++n) _Pragma("unroll") for (int k = 0; k < 2; ++k) \
        acc[ai][bj][m][n] = __builtin_amdgcn_mfma_f32_16x16x32_bf16(Bt[n][k], At[m][k], acc[ai][bj][m][n], 0, 0, 0); __builtin_amdgcn_s_setprio(0); } while (0)
#define PG8_WAIT_V(n) asm volatile("s_waitcnt vmcnt(" #n ")" ::: "memory")
#define PG8_WAIT_L(n) asm volatile("s_waitcnt lgkmcnt(" #n ")" ::: "memory")
#define PG8_BAR __builtin_amdgcn_s_barrier()
#define PG8_SCHED __builtin_amdgcn_sched_barrier(0)
    Unit cur, nxt; int ui = 0;
    if (!S.next(0, cur)) return;
    f32x4 acc[2][2][4][2];
#pragma unroll
    for (int a = 0; a < 2; ++a)
#pragma unroll
        for (int b = 0; b < 2; ++b)
#pragma unroll
            for (int m = 0; m < 4; ++m)
#pragma unroll
                for (int n = 0; n < 2; ++n) acc[a][b][m][n] = (f32x4){0.f, 0.f, 0.f, 0.f};
    bf16x8 At[4][2], B0[2][2], B1[2][2];
    const char* cA = (const char*)g.A + (size_t)cur.pm * tstep; const char* cB = (const char*)g.Bt + (size_t)cur.pn * tstep;
    S.a_ready(cur);
    PG8_STAGE(PG8_SB(0, 0), cB, voffB); PG8_STAGE(PG8_SA(0, 0), cA, voffA); PG8_STAGE(PG8_SB(0, 1), cB + hstep, voffB); PG8_STAGE(PG8_SA(0, 1), cA + hstep, voffA);
    if (wr == 1) PG8_BAR;
    PG8_WAIT_V(4); PG8_BAR;
    PG8_STAGE(PG8_SB(1, 0), cB + kstep, voffB); PG8_STAGE(PG8_SA(1, 0), cA + kstep, voffA); PG8_STAGE(PG8_SB(1, 1), cB + hstep + kstep, voffB);
    PG8_WAIT_V(6); PG8_BAR;
    PG8_STAMP();
    for (;;) {
        const bool has_next = S.next(ui + 1, nxt);
        const char* nA = has_next ? (const char*)g.A + (size_t)nxt.pm * tstep : cA; const char* nB = has_next ? (const char*)g.Bt + (size_t)nxt.pn * tstep : cB;
        for (int t = 0; t < nt; t += 2) {
            const bool last = (t == nt - 2);
            const char* a1 = cA + (size_t)(t + 1) * kstep;
            const char* a2 = last ? nA : cA + (size_t)(t + 2) * kstep; const char* b2 = last ? nB : cB + (size_t)(t + 2) * kstep;
            const char* a3 = a2 + kstep; const char* b3 = b2 + kstep;
            if (last && has_next) S.a_ready(nxt);
            PG8_LDB(B0, 0, 0); PG8_SCHED; PG8_LDA(At, 0, 0); PG8_STAGE(PG8_SA(1, 1), a1 + hstep, voffA);
            PG8_WAIT_L(8); PG8_BAR; PG8_WAIT_L(0); PG8_MMA(0, 0, At, B0); PG8_BAR; PG8_SCHED;
            PG8_LDB(B1, 0, 1); PG8_STAGE(PG8_SB(0, 0), b2, voffB);
            PG8_BAR; PG8_WAIT_L(0); PG8_MMA(0, 1, At, B1); PG8_BAR;
            PG8_LDA(At, 0, 1); PG8_STAGE(PG8_SA(0, 0), a2, voffA);
            PG8_BAR; PG8_WAIT_L(0); PG8_MMA(1, 0, At, B0); PG8_BAR; PG8_SCHED;
            PG8_STAGE(PG8_SB(0, 1), b2 + hstep, voffB);
            PG8_WAIT_V(6); PG8_BAR; PG8_MMA(1, 1, At, B1); PG8_BAR;
            PG8_LDB(B0, 1, 0); PG8_SCHED; PG8_LDA(At, 1, 0); PG8_STAGE(PG8_SA(0, 1), a2 + hstep, voffA);
            PG8_WAIT_L(8); PG8_BAR; PG8_WAIT_L(0); PG8_MMA(0, 0, At, B0); PG8_BAR; PG8_SCHED;
            PG8_LDB(B1, 1, 1); PG8_STAGE(PG8_SB(1, 0), b3, voffB);
            PG8_BAR; PG8_WAIT_L(0); PG8_MMA(0, 1, At, B1); PG8_BAR;
            PG8_LDA(At, 1, 1); PG8_STAGE(PG8_SA(1, 0), a3, voffA);
            PG8_BAR; PG8_WAIT_L(0); PG8_MMA(1, 0, At, B0); PG8_BAR; PG8_SCHED;
            PG8_STAGE(PG8_SB(1, 1), b3 + hstep, voffB);
            PG8_WAIT_V(6); PG8_BAR; PG8_MMA(1, 1, At, B1); PG8_BAR;
        }
        PG8_STAMP();
        if constexpr (ALIGN_EPI) { if (wr == 0) PG8_BAR; }
        if constexpr (!Epi::AFTER_DRAIN) { E(acc, cur, wr, wc, fr, fq); S.done(cur); }
        PG8_STAMP();
        if (!has_next) break;
#pragma unroll
        for (int a = 0; a < 2; ++a)
#pragma unroll
            for (int b = 0; b < 2; ++b)
#pragma unroll
                for (int m = 0; m < 4; ++m)
#pragma unroll
                    for (int n = 0; n < 2; ++n) acc[a][b][m][n] = (f32x4){0.f, 0.f, 0.f, 0.f};
        cur = nxt; cA = nA; cB = nB; ++ui;
        if constexpr (ALIGN_EPI) { if (wr == 1) PG8_BAR; }
    }
    PG8_WAIT_V(0);
    if constexpr (!ALIGN_EPI) { if (wr == 0) PG8_BAR; }
    PG8_BAR;
    if constexpr (Epi::AFTER_DRAIN) { E.fused(acc, cur, wr, wc, fr, fq, lds, wid, lane); S.done(cur); }
    PG8_STAMP();
    if (STAMP && wid == 0) { stamps[lane] = lane < nts ? (((unsigned long long)(unsigned)ts_hi << 32) | (unsigned)ts_lo) : 0ull;
        if (lane == 62) stamps[62] = rt_entry; if (lane == 63) stamps[63] = (unsigned long long)wall_clock64(); }
#undef PG8_STAMP
#undef PG8_SA
#undef PG8_SB
#undef PG8_STAGE
#undef PG8_LDA
#undef PG8_LDB
#undef PG8_MMA
#undef PG8_WAIT_V
#undef PG8_WAIT_L
#undef PG8_BAR
#undef PG8_SCHED
}
}
#define LAS __attribute__((address_space(3)))
#define XB_TMO      128
#define XB_XCNT(j)  (256  + 64 * (j))
#define XB_XSUB(j)  (1280 + 64 * (j))
#define XB_XGEN(j)  (2304 + 64 * (j))
#define XB_TOP      3328
#define XB_TOPGEN   3392
#define XCD_BAR_WORDS 3456
#define XB_SPIN_CAP (1u << 18)
typedef unsigned short bf16_t;
typedef short bf16x8 __attribute__((ext_vector_type(8)));
typedef float f32x4 __attribute__((ext_vector_type(4)));
typedef unsigned u32x4 __attribute__((ext_vector_type(4)));

constexpr int MP = 65536, MS = 512, MT = 66048;
constexpr int NTHR = 512, NWV = 8;
constexpr size_t al256(size_t x) { return (x + 255) & ~(size_t)255; }
constexpr size_t WS_ADA  = 0;
constexpr size_t WS_BT1  = al256(WS_ADA + 40 * 3072 * 4);
constexpr size_t WS_BT2  = al256(WS_BT1 + (size_t)4096 * 1024 * 2);
constexpr size_t WS_WG   = al256(WS_BT2 + (size_t)1024 * 1536 * 2);
constexpr size_t WS_AGG  = al256(WS_WG + 131072 * 2);
constexpr size_t WS_BAR  = al256(WS_AGG + (size_t)8 * 16 * 1024 * 2 * 4);
constexpr size_t WS_CNT  = al256(WS_BAR + XCD_BAR_WORDS * 4);
constexpr size_t WS_RSS  = al256(WS_CNT + (size_t)258 * 2 * 256);
constexpr size_t WS_HN   = al256(WS_RSS + (size_t)MT * 16 * 4);
constexpr size_t WS_LB   = WS_HN;
constexpr size_t WS_PROJ = al256(WS_HN + (size_t)MT * 1024 * 4);
constexpr size_t WS_YMIX = al256(WS_PROJ + (size_t)MT * 4096 * 2);
constexpr size_t WS_OM   = WS_HN;
constexpr size_t WS_END  = al256(WS_YMIX + (size_t)MT * 1536 * 2);
constexpr size_t O_Y = 0, O_CAP = (size_t)MT * 1024, O_LRP = O_CAP + 8 * 3 * 1024, O_CBP = O_LRP + 8 * 1024, O_CAS = O_CBP + 8 * 2 * 512,
                 O_LRS = O_CAS + 32 * 3 * 1024, O_CBS = O_LRS + 32 * 1024, O_END = O_CBS + 32 * 2 * 512;

struct Args {
    const float *xp, *xs, *cp, *cs, *cache_a, *state, *cache_b, *g_norm, *w_ada, *b_ada, *w_in, *w_conv_a, *b_conv_a, *w_rg, *b_rg, *w_ig, *b_ig, *lam, *w_conv_b, *w_out, *g_final;
    float* out; unsigned char* ws; int ph_lo, ph_hi;
};

__device__ __forceinline__ float bf_lo(unsigned u) { return __uint_as_float(u << 16); }
__device__ __forceinline__ float bf_hi(unsigned u) { return __uint_as_float(u & 0xffff0000u); }
__device__ __forceinline__ void unpack8(const u32x4 v, float* f) { f[0] = bf_lo(v.x); f[1] = bf_hi(v.x); f[2] = bf_lo(v.y); f[3] = bf_hi(v.y); f[4] = bf_lo(v.z); f[5] = bf_hi(v.z); f[6] = bf_lo(v.w); f[7] = bf_hi(v.w); }
__device__ __forceinline__ u32x4 pack8(const float* f) { u32x4 w; w.x = pg8::cvt_pk_bf16(f[0], f[1]); w.y = pg8::cvt_pk_bf16(f[2], f[3]); w.z = pg8::cvt_pk_bf16(f[4], f[5]); w.w = pg8::cvt_pk_bf16(f[6], f[7]); return w; }
__device__ __forceinline__ float sigmoidf_(float x) { return __builtin_amdgcn_rcpf(1.f + __builtin_amdgcn_exp2f(-1.44269504f * x)); }
template <int CTRL> __device__ __forceinline__ float dpp_keep(float old, float src) { return __int_as_float(__builtin_amdgcn_update_dpp(__float_as_int(old), __float_as_int(src), CTRL, 0xF, 0xF, false)); }


__device__ __forceinline__ unsigned xb_ld(unsigned* p)              { return __hip_atomic_load(p, __ATOMIC_RELAXED, __HIP_MEMORY_SCOPE_AGENT); }
__device__ __forceinline__ unsigned xb_add(unsigned* p, unsigned v) { return __hip_atomic_fetch_add(p, v, __ATOMIC_RELAXED, __HIP_MEMORY_SCOPE_AGENT); }
__device__ __forceinline__ unsigned xb_xcc_id() { return (unsigned)__builtin_amdgcn_s_getreg((3 << 11) | 20) & 0xFu; }
#define XB_SPIN(cond, bar) do { unsigned _sp = 0; while (cond) { __builtin_amdgcn_s_sleep(1); \
    if ((++_sp & 255u) == 0u) { if (xb_ld(&(bar)[XB_TMO])) break; if (_sp > XB_SPIN_CAP) { atomicAdd(&(bar)[XB_TMO], 1u); break; } } } } while (0)
struct XcdBarrier {
    unsigned* bar; unsigned x;
    volatile LAS unsigned* st;
};

__device__ __forceinline__ XcdBarrier xcd_barrier_post(unsigned* bar, volatile LAS unsigned* st) {
    XcdBarrier b; b.bar = bar; b.x = xb_xcc_id(); b.st = st;
    if (threadIdx.x == 0) (void)xb_add(&bar[XB_XCNT(b.x)], 1u);
    return b;
}
__device__ __forceinline__ void xcd_barrier_complete(unsigned* bar, unsigned x, unsigned& nloc, unsigned& nx) {
    const unsigned G = gridDim.x * gridDim.y * gridDim.z;
    unsigned sum, cnt, mine, sp = 0u;
    for (;;) {
        sum = 0u; cnt = 0u; mine = 0u;
#pragma unroll
        for (unsigned j = 0; j < 16; ++j) { const unsigned c = xb_ld(&bar[XB_XCNT(j)]); sum += c; cnt += (c > 0u) ? 1u : 0u; mine = (j == x) ? c : mine; }
        if (sum == G) break;
        __builtin_amdgcn_s_sleep(1);
        if ((++sp & 255u) == 0u) { if (xb_ld(&bar[XB_TMO])) break; if (sp > XB_SPIN_CAP) { atomicAdd(&bar[XB_TMO], 1u); break; } }
    }
    nloc = mine > 0u ? mine : 1u; nx = cnt > 0u ? cnt : 1u;
}

__device__ __forceinline__ void xcd_barrier(const XcdBarrier& b) {
    asm volatile("s_waitcnt vmcnt(0)" ::: "memory");
    __syncthreads();
    if (threadIdx.x == 0) {
        unsigned* bar = b.bar;
        __builtin_amdgcn_s_waitcnt(0);
        unsigned nloc = b.st[0], nx = b.st[1];
        if (nloc == 0u) { xcd_barrier_complete(bar, b.x, nloc, nx); b.st[0] = nloc; b.st[1] = nx; }
        const unsigned old = xb_add(&bar[XB_XSUB(b.x)], 1u);
        const unsigned gen = old / nloc;
        if (old + 1u == (gen + 1u) * nloc) {
            __builtin_amdgcn_fence(__ATOMIC_RELEASE, "agent");
            asm volatile("s_waitcnt vmcnt(0)" ::: "memory");
            const unsigned og = xb_add(&bar[XB_TOP], 1u);
            const unsigned tg = og / nx;
            if (og + 1u == (tg + 1u) * nx) xb_add(&bar[XB_TOPGEN], 1u);
            else XB_SPIN(xb_ld(&bar[XB_TOPGEN]) == tg, bar);
            __builtin_amdgcn_fence(__ATOMIC_ACQUIRE, "agent");
            xb_add(&bar[XB_XGEN(b.x)], 1u);
            asm volatile("s_waitcnt vmcnt(0)" ::: "memory");
        } else {
            XB_SPIN(xb_ld(&bar[XB_XGEN(b.x)]) == gen, bar);
            __builtin_amdgcn_fence(__ATOMIC_ACQUIRE, "agent");
            asm volatile("s_waitcnt vmcnt(0)" ::: "memory");
        }
    }
    __syncthreads();
}

#define XB_REC_WORDS 32

__device__ __forceinline__ void scan4(float& a0, float& a1, float& a2, float& a3, float& b0, float& b1, float& b2, float& b3, float h0, float h1, float h2, float h3) {
#define DPPM " row_mask:0xf bank_mask:0xf\n\t"
#define STEP(N) "v_fmac_f32_dpp %4, %4, %0 row_shr:" #N DPPM "v_fmac_f32_dpp %5, %5, %1 row_shr:" #N DPPM "v_fmac_f32_dpp %6, %6, %2 row_shr:" #N DPPM "v_fmac_f32_dpp %7, %7, %3 row_shr:" #N DPPM \
                "v_mul_f32_dpp %0, %0, %0 row_shr:" #N DPPM "v_mul_f32_dpp %1, %1, %1 row_shr:" #N DPPM "v_mul_f32_dpp %2, %2, %2 row_shr:" #N DPPM "v_mul_f32_dpp %3, %3, %3 row_shr:" #N DPPM
    asm volatile("s_nop 1\n\t"
        "v_fmac_f32_dpp %4, %8, %0 row_ror:1" DPPM "v_fmac_f32_dpp %5, %9, %1 row_ror:1" DPPM "v_fmac_f32_dpp %6, %10, %2 row_ror:1" DPPM "v_fmac_f32_dpp %7, %11, %3 row_ror:1" DPPM
        STEP(1) STEP(2) STEP(4) STEP(8)
        : "+v"(a0), "+v"(a1), "+v"(a2), "+v"(a3), "+v"(b0), "+v"(b1), "+v"(b2), "+v"(b3) : "v"(h0), "v"(h1), "v"(h2), "v"(h3));
#undef STEP
#undef DPPM
}

__device__ void p0_prologue(const Args& a, LAS unsigned char* lds) {
    const int tid = threadIdx.x, bx = blockIdx.x, G = gridDim.x;
    float* ada = (float*)(a.ws + WS_ADA);
    { unsigned* cz = (unsigned*)(a.ws + WS_CNT); for (int i = bx * NTHR + tid; i < 258 * 2 * 64; i += G * NTHR) cz[i] = 0u; }
    for (int it = bx; it < 192; it += G) {
        LAS float* sS = (LAS float*)lds; LAS float* red = (LAS float*)(lds + 40 * 256 * 4);
        const int n0 = it * 16, kq = tid >> 4, col = tid & 15;
        float acc[40];
#pragma unroll
        for (int b = 0; b < 40; ++b) acc[b] = 0.f;
        for (int kc = 0; kc < 4; ++kc) {
            __syncthreads();
            for (int i = tid; i < 40 * 256; i += NTHR) { const int b = i >> 8, kk = i & 255;
                const float cv = b < 8 ? a.cp[b * 1024 + kc * 256 + kk] : a.cs[(b - 8) * 1024 + kc * 256 + kk];
                sS[i] = cv * sigmoidf_(cv); }
            __syncthreads();
#pragma unroll
            for (int k8 = 0; k8 < 8; ++k8) { const float w = a.w_ada[(size_t)(kc * 256 + kq * 8 + k8) * 3072 + n0 + col];
#pragma unroll
                for (int b = 0; b < 40; ++b) acc[b] += sS[b * 256 + kq * 8 + k8] * w; }
        }
#pragma unroll
        for (int b = 0; b < 40; ++b) red[kq * 640 + col * 40 + b] = acc[b];
        __syncthreads();
        for (int o = tid; o < 640; o += NTHR) { float s = 0.f; for (int k = 0; k < 32; ++k) s += red[k * 640 + o];
            const int c = o / 40, b = o % 40; ada[b * 3072 + n0 + c] = s + a.b_ada[n0 + c]; }
        __syncthreads();
    }
    {
        LAS float* tile = (LAS float*)lds;
        for (int tl = bx; tl < 1024 + 384; tl += G) {
            const float* src; bf16_t* dst; int K, N, kt, nt;
            if (tl < 1024) { src = a.w_in; dst = (bf16_t*)(a.ws + WS_BT1); K = 1024; N = 4096; kt = tl >> 6; nt = tl & 63; }
            else { const int t2 = tl - 1024; src = a.w_out; dst = (bf16_t*)(a.ws + WS_BT2); K = 1536; N = 1024; kt = t2 >> 4; nt = t2 & 15; }
            __syncthreads();
#pragma unroll
            for (int ps = 0; ps < 2; ++ps) { const int rr = (tid >> 4) + ps * 32, c4 = (tid & 15) * 4;
                const f32x4 v = *(const f32x4*)(src + (size_t)(kt * 64 + rr) * N + nt * 64 + c4);
                tile[rr * 65 + c4 + 0] = v[0]; tile[rr * 65 + c4 + 1] = v[1]; tile[rr * 65 + c4 + 2] = v[2]; tile[rr * 65 + c4 + 3] = v[3]; }
            __syncthreads();
            { const int n = tid >> 3, k8 = tid & 7; float f[8];
#pragma unroll
              for (int e = 0; e < 8; ++e) f[e] = tile[(k8 * 8 + e) * 65 + n];
              *(u32x4*)(dst + (size_t)(nt * 64 + n) * K + kt * 64 + k8 * 8) = pack8(f); }
        }
        __syncthreads();
    }
    {
        bf16_t* wg = (bf16_t*)(a.ws + WS_WG);
        for (int i = bx * NTHR + tid; i < 131072; i += G * NTHR) {
            const int e = i & 7, lane = (i >> 3) & 63, ks = (i >> 9) & 1, nb = (i >> 10) & 3, g = (i >> 12) & 1, h = i >> 13;
            const int m = lane & 15, q = lane >> 4;
            const int k = ks * 32 + q * 8 + e, n = (nb >> 1) * 32 + (m >> 2) * 8 + (nb & 1) * 4 + (m & 3);
            const float v = (g ? a.w_ig : a.w_rg)[(size_t)h * 4096 + k * 64 + n];
            wg[i] = (bf16_t)(pg8::cvt_pk_bf16(-1.44269504f * v, 0.f) & 0xffffu);
        }
    }
}

__device__ void p1_norm(const Args& a) {
    const int lane = threadIdx.x & 63, gw = blockIdx.x * NWV + (threadIdx.x >> 6), nw = gridDim.x * NWV;
    const float* ada = (const float*)(a.ws + WS_ADA); bf16_t* hn = (bf16_t*)(a.ws + WS_HN);
    for (int rowa = gw; rowa < MT; rowa += 2 * nw) {
        const int nr = (rowa + nw < MT) ? 2 : 1;
        f32x4 v[2][4]; float ss[2] = {0.f, 0.f};
#pragma unroll
        for (int k = 0; k < 2; ++k) { const int row = (k < nr) ? rowa + k * nw : rowa;
            const float* xr = row < MP ? a.xp + (size_t)row * 1024 : a.xs + (size_t)(row - MP) * 1024;
#pragma unroll
            for (int i = 0; i < 4; ++i) v[k][i] = *(const f32x4*)(xr + (i * 64 + lane) * 4); }
#pragma unroll
        for (int k = 0; k < 2; ++k) {
#pragma unroll
            for (int i = 0; i < 4; ++i) ss[k] += v[k][i][0] * v[k][i][0] + v[k][i][1] * v[k][i][1] + v[k][i][2] * v[k][i][2] + v[k][i][3] * v[k][i][3];
#pragma unroll
            for (int o = 1; o < 64; o <<= 1) ss[k] += __shfl_xor(ss[k], o); }
#pragma unroll
        for (int k = 0; k < 2; ++k) { if (k < nr) { const int row = rowa + k * nw;
            const int b = row < MP ? (row >> 13) : 8 + ((row - MP) >> 4);
            const float rinv = rsqrtf(ss[k] * (1.f / 1024.f) + 1e-6f);
#pragma unroll
            for (int i = 0; i < 4; ++i) { const int c = (i * 64 + lane) * 4;
                const f32x4 g = *(const f32x4*)(a.g_norm + c), sc = *(const f32x4*)(ada + b * 3072 + 1024 + c), sh = *(const f32x4*)(ada + b * 3072 + c);
                const f32x4 o = (v[k][i] * rinv) * g * (sc + 1.f) + sh;
                uint2 w; w.x = pg8::cvt_pk_bf16(o[0], o[1]); w.y = pg8::cvt_pk_bf16(o[2], o[3]);
                *(uint2*)(hn + (size_t)row * 1024 + c) = w; } } }
    }
}

__device__ void p3_mixer_a1(const Args& a, LAS unsigned char* lds, const int gw, const int nw) {
    const int lane = threadIdx.x & 63, wv = threadIdx.x >> 6;
    const int r = lane & 15, q = lane >> 4;
    LAS float* tbl = (LAS float*)(lds + wv * 2048);
    const bf16_t* proj = (const bf16_t*)(a.ws + WS_PROJ); unsigned* LB = (unsigned*)(a.ws + WS_LB);
    float* agg = (float*)(a.ws + WS_AGG);
    for (int u = gw; u < 2560; u += nw) {
        int head, seq, chunk, L, tstart; size_t rowbase; bool sample, lastchunk;
        if (u < 2048) { head = u & 15; chunk = (u >> 4) & 15; seq = u >> 8; sample = false; rowbase = (size_t)seq * 8192; tstart = chunk * 512; L = 32; lastchunk = (chunk == 15); }
        else { const int v = u - 2048; head = v & 15; seq = v >> 4; chunk = 0; sample = true; rowbase = (size_t)MP + seq * 16; tstart = 0; L = 1; lastchunk = true; }
        __builtin_amdgcn_wave_barrier();
        { const int c = head * 64 + lane;
          tbl[0 * 64 + lane] = a.w_conv_a[0 * 1024 + c]; tbl[1 * 64 + lane] = a.w_conv_a[1 * 1024 + c]; tbl[2 * 64 + lane] = a.w_conv_a[2 * 1024 + c]; tbl[3 * 64 + lane] = a.w_conv_a[3 * 1024 + c];
          tbl[4 * 64 + lane] = a.b_conv_a[c]; tbl[5 * 64 + lane] = -1.44269504f * a.b_rg[c]; tbl[6 * 64 + lane] = -1.44269504f * a.b_ig[c];
          tbl[7 * 64 + lane] = -8.f * 1.44269504f * log1pf(__expf(-a.lam[c])); }
        __builtin_amdgcn_wave_barrier();
        bf16x8 wg[2][4][2];
        { const bf16x8* wgp = (const bf16x8*)(a.ws + WS_WG);
#pragma unroll
          for (int g = 0; g < 2; ++g)
#pragma unroll
            for (int nb = 0; nb < 4; ++nb)
#pragma unroll
              for (int ks = 0; ks < 2; ++ks) wg[g][nb][ks] = wgp[((((head * 2 + g) * 4 + nb) * 2 + ks) * 64) + lane]; }
        float hrun[16], prun[16];
#pragma unroll
        for (int i = 0; i < 16; ++i) { hrun[i] = 0.f; prun[i] = 1.f; }
        const int cb0 = head * 64 + q * 8;
        const int t0 = tstart + r * L;
        const bf16_t* prow = proj + (rowbase + t0) * 4096 + cb0;
        u32x4 W[3][2], Xn[2], Xn2[2];
#pragma unroll
        for (int kk = 0; kk < 3; ++kk)
#pragma unroll
            for (int ks = 0; ks < 2; ++ks) {
                const int trel = t0 - 3 + kk;
                u32x4 v = (u32x4){0u, 0u, 0u, 0u};
                if (trel >= 0) v = *(const u32x4*)(prow + (ptrdiff_t)(kk - 3) * 4096 + ks * 32);
                else if (sample) { const float* cpn = a.cache_a + ((size_t)seq * 3 + (3 + trel)) * 1024 + cb0 + ks * 32; float f[8];
#pragma unroll
                    for (int e = 0; e < 8; ++e) f[e] = cpn[e];
                    v = pack8(f); }
                W[kk][ks] = v; }
#pragma unroll
        for (int ks = 0; ks < 2; ++ks) { Xn[ks] = *(const u32x4*)(prow + ks * 32); Xn2[ks] = *(const u32x4*)(prow + (size_t)(L > 1 ? 1 : 0) * 4096 + ks * 32); }
        for (int blk = 0; blk < L; ++blk) {
            const size_t row = rowbase + t0 + blk;
            u32x4 Xc[2];
#pragma unroll
            for (int ks = 0; ks < 2; ++ks) { Xc[ks] = Xn[ks]; Xn[ks] = Xn2[ks]; }
            { const int nb2 = (blk + 2 < L) ? blk + 2 : L - 1;
#pragma unroll
              for (int ks = 0; ks < 2; ++ks) Xn2[ks] = *(const u32x4*)(prow + (size_t)nb2 * 4096 + ks * 32); }
            float xc[16]; bf16x8 af[2];
#pragma unroll
            for (int ks = 0; ks < 2; ++ks) {
                const int cl0 = ks * 32 + q * 8;
                float acc8[8];
                { const f32x4 b0 = *(const LAS f32x4*)(tbl + 4 * 64 + cl0), b1 = *(const LAS f32x4*)(tbl + 4 * 64 + cl0 + 4);
                  acc8[0] = b0[0]; acc8[1] = b0[1]; acc8[2] = b0[2]; acc8[3] = b0[3]; acc8[4] = b1[0]; acc8[5] = b1[1]; acc8[6] = b1[2]; acc8[7] = b1[3]; }
#pragma unroll
                for (int kk = 0; kk < 4; ++kk) {
                    float X[8]; unpack8(kk < 3 ? W[kk][ks] : Xc[ks], X);
                    const f32x4 w0 = *(const LAS f32x4*)(tbl + kk * 64 + cl0), w1 = *(const LAS f32x4*)(tbl + kk * 64 + cl0 + 4);
                    acc8[0] += w0[0] * X[0]; acc8[1] += w0[1] * X[1]; acc8[2] += w0[2] * X[2]; acc8[3] += w0[3] * X[3];
                    acc8[4] += w1[0] * X[4]; acc8[5] += w1[1] * X[5]; acc8[6] += w1[2] * X[6]; acc8[7] += w1[3] * X[7];
                }
#pragma unroll
                for (int e = 0; e < 8; ++e) xc[ks * 8 + e] = acc8[e];
                const u32x4 pk = pack8(acc8);
                af[ks] = __builtin_bit_cast(bf16x8, pk);
            }
            if (lastchunk && blk == L - 1 && r == 15) {
#pragma unroll
                for (int kk = 1; kk < 4; ++kk)
#pragma unroll
                    for (int ks = 0; ks < 2; ++ks) { float X[8]; unpack8(kk < 3 ? W[kk][ks] : Xc[ks], X);
                        float* o = a.out + (sample ? O_CAS : O_CAP) + ((size_t)seq * 3 + (kk - 1)) * 1024 + cb0 + ks * 32;
                        *(f32x4*)o = (f32x4){X[0], X[1], X[2], X[3]}; *(f32x4*)(o + 4) = (f32x4){X[4], X[5], X[6], X[7]}; }
            }
#pragma unroll
            for (int nb = 0; nb < 4; ++nb) {
                const int ks = nb >> 1, e0 = (nb & 1) * 4, cl0 = ks * 32 + q * 8 + e0, i0 = ks * 8 + e0;
                const f32x4 brg = *(const LAS f32x4*)(tbl + 5 * 64 + cl0), big = *(const LAS f32x4*)(tbl + 6 * 64 + cl0), nsp = *(const LAS f32x4*)(tbl + 7 * 64 + cl0);
                f32x4 R = __builtin_amdgcn_mfma_f32_16x16x32_bf16(wg[0][nb][0], af[0], brg, 0, 0, 0);
                R = __builtin_amdgcn_mfma_f32_16x16x32_bf16(wg[0][nb][1], af[1], R, 0, 0, 0);
                f32x4 I = __builtin_amdgcn_mfma_f32_16x16x32_bf16(wg[1][nb][0], af[0], big, 0, 0, 0);
                I = __builtin_amdgcn_mfma_f32_16x16x32_bf16(wg[1][nb][1], af[1], I, 0, 0, 0);
                u32x4 lbw;
#pragma unroll
                for (int j = 0; j < 4; ++j) {
                    const float rg = __builtin_amdgcn_rcpf(1.f + __builtin_amdgcn_exp2f(R[j]));
                    const float ig = __builtin_amdgcn_rcpf(1.f + __builtin_amdgcn_exp2f(I[j]));
                    const float la2 = nsp[j] * rg;
                    const float av = __builtin_amdgcn_exp2f(la2);
                    const float bb = __builtin_amdgcn_sqrtf(__builtin_fmaf(-av, av, 1.f)) * (ig * xc[i0 + j]);
                    lbw[j] = pg8::cvt_pk_bf16(la2, bb);
                    hrun[i0 + j] = __builtin_fmaf(av, hrun[i0 + j], bb);
                    prun[i0 + j] *= av;
                }
                *(u32x4*)(LB + row * 1024 + head * 64 + cl0) = lbw;
            }
#pragma unroll
            for (int ks = 0; ks < 2; ++ks) { W[0][ks] = W[1][ks]; W[1][ks] = W[2][ks]; W[2][ks] = Xc[ks]; }
        }
        if (!sample) {
#pragma unroll
            for (int g4 = 0; g4 < 4; ++g4) { const int i0 = g4 * 4;
                scan4(prun[i0], prun[i0 + 1], prun[i0 + 2], prun[i0 + 3], hrun[i0], hrun[i0 + 1], hrun[i0 + 2], hrun[i0 + 3], 0.f, 0.f, 0.f, 0.f); }
            if (r == 15) {
#pragma unroll
                for (int i = 0; i < 16; ++i) *(float2*)(agg + ((size_t)(seq * 16 + chunk) * 1024 + head * 64 + (i >> 3) * 32 + q * 8 + (i & 7)) * 2) = make_float2(prun[i], hrun[i]);
            }
        }
    }
}

struct A2Regs { u32x4 lb[4]; u32x4 g[2]; };
__device__ __forceinline__ void a2_load(A2Regs& R, const unsigned* LB, const bf16_t* proj, size_t row, int cb) {
#pragma unroll
    for (int ks = 0; ks < 2; ++ks) { const unsigned* lp = LB + row * 1024 + cb + ks * 32; R.lb[ks * 2] = *(const u32x4*)lp; R.lb[ks * 2 + 1] = *(const u32x4*)(lp + 4);
        R.g[ks] = *(const u32x4*)(proj + row * 4096 + 1024 + cb + ks * 32); }
}
__device__ __forceinline__ void a2_block(const A2Regs& R, float (&hprev)[16], bf16_t* ymix, size_t row, int cb, int r) {
#pragma unroll
    for (int ks = 0; ks < 2; ++ks) {
        float G[8]; unpack8(R.g[ks], G);
        float y[8];
#pragma unroll
        for (int hh = 0; hh < 2; ++hh) {
            const u32x4 w = R.lb[ks * 2 + hh]; const int i0 = ks * 8 + hh * 4;
            float av[4], bb[4], hm[4];
#pragma unroll
            for (int j = 0; j < 4; ++j) { av[j] = __builtin_amdgcn_exp2f(bf_lo(w[j])); bb[j] = bf_hi(w[j]); hm[j] = (r == 15) ? hprev[i0 + j] : 0.f; }
            scan4(av[0], av[1], av[2], av[3], bb[0], bb[1], bb[2], bb[3], hm[0], hm[1], hm[2], hm[3]);
#pragma unroll
            for (int j = 0; j < 4; ++j) { hprev[i0 + j] = bb[j]; const float g = G[hh * 4 + j]; y[hh * 4 + j] = bb[j] * (g * sigmoidf_(g)); }
        }
        *(u32x4*)(ymix + row * 1536 + cb + ks * 32) = pack8(y);
    }
}
__device__ void p4_mixer_a2(const Args& a) {
    const int lane = threadIdx.x & 63, wv = threadIdx.x >> 6, gw = blockIdx.x * NWV + wv, nw = gridDim.x * NWV;
    const int r = lane & 15, q = lane >> 4;
    const bf16_t* proj = (const bf16_t*)(a.ws + WS_PROJ); bf16_t* ymix = (bf16_t*)(a.ws + WS_YMIX); const unsigned* LB = (const unsigned*)(a.ws + WS_LB);
    const float* agg = (const float*)(a.ws + WS_AGG);
    for (int u = gw; u < 2560; u += nw) {
        int head, seq, chunk, nblk, tstart; size_t rowbase; bool sample, lastchunk;
        if (u < 2048) { head = u & 15; chunk = (u >> 4) & 15; seq = u >> 8; sample = false; rowbase = (size_t)seq * 8192; tstart = chunk * 512; nblk = 32; lastchunk = (chunk == 15); }
        else { const int v = u - 2048; head = v & 15; seq = v >> 4; chunk = 0; sample = true; rowbase = (size_t)MP + seq * 16; tstart = 0; nblk = 1; lastchunk = true; }
        const int cb = head * 64 + q * 8;
        float hprev[16];
#pragma unroll
        for (int i = 0; i < 16; ++i) hprev[i] = 0.f;
        if (sample) {
#pragma unroll
            for (int i = 0; i < 16; ++i) hprev[i] = a.state[(size_t)seq * 1024 + cb + (i >> 3) * 32 + (i & 7)];
        } else {
            for (int jj = 0; jj < chunk; ++jj) {
#pragma unroll
                for (int i = 0; i < 16; ++i) { const float2 ph = *(const float2*)(agg + ((size_t)(seq * 16 + jj) * 1024 + cb + (i >> 3) * 32 + (i & 7)) * 2);
                    hprev[i] = ph.x * hprev[i] + ph.y; }
            }
        }
        const size_t row0 = rowbase + tstart + r;
        if (nblk == 1) { A2Regs c0; a2_load(c0, LB, proj, row0, cb); a2_block(c0, hprev, ymix, row0, cb, r); }
        else {
            A2Regs c0, c1, n0, n1;
            a2_load(c0, LB, proj, row0, cb); a2_load(c1, LB, proj, row0 + 16, cb);
            for (int blk = 0; blk < nblk; blk += 2) {
                const size_t row = row0 + (size_t)blk * 16;
                const size_t rown = (blk + 2 < nblk) ? row + 32 : row;
                a2_load(n0, LB, proj, rown, cb); a2_load(n1, LB, proj, rown + 16, cb);
                a2_block(c0, hprev, ymix, row, cb, r); a2_block(c1, hprev, ymix, row + 16, cb, r);
                c0 = n0; c1 = n1;
            }
        }
        if (lastchunk && r == 15) {
#pragma unroll
            for (int ks = 0; ks < 2; ++ks) { float* o = a.out + (sample ? O_LRS : O_LRP) + (size_t)seq * 1024 + cb + ks * 32;
                *(f32x4*)o = (f32x4){hprev[ks * 8 + 0], hprev[ks * 8 + 1], hprev[ks * 8 + 2], hprev[ks * 8 + 3]};
                *(f32x4*)(o + 4) = (f32x4){hprev[ks * 8 + 4], hprev[ks * 8 + 5], hprev[ks * 8 + 6], hprev[ks * 8 + 7]}; }
        }
    }
}

__device__ void p3_mixer_b(const Args& a, const int tix, const int tn) {
    const bf16_t* proj = (const bf16_t*)(a.ws + WS_PROJ); bf16_t* ymix = (bf16_t*)(a.ws + WS_YMIX);
    for (int it = tix; it < (MP / 16) * 64; it += tn) {
        const int rb = it >> 6, cg = it & 63, c0 = cg * 8;
        const int seq = rb >> 9, t0 = (rb & 511) * 16;
        const size_t rowbase = (size_t)seq * 8192;
        float w[3][8];
#pragma unroll
        for (int k = 0; k < 3; ++k) { const f32x4 w0 = *(const f32x4*)(a.w_conv_b + k * 512 + c0), w1 = *(const f32x4*)(a.w_conv_b + k * 512 + c0 + 4);
            w[k][0] = w0[0]; w[k][1] = w0[1]; w[k][2] = w0[2]; w[k][3] = w0[3]; w[k][4] = w1[0]; w[k][5] = w1[1]; w[k][6] = w1[2]; w[k][7] = w1[3]; }
        float vm2[8], vm1[8];
        if (t0 > 0) {
            float xa[8], ca[8];
            unpack8(*(const u32x4*)(proj + (rowbase + t0 - 2) * 4096 + 2048 + c0), xa); unpack8(*(const u32x4*)(proj + (rowbase + t0 - 2) * 4096 + 3072 + c0), ca);
#pragma unroll
            for (int e = 0; e < 8; ++e) vm2[e] = xa[e] * ca[e];
            unpack8(*(const u32x4*)(proj + (rowbase + t0 - 1) * 4096 + 2048 + c0), xa); unpack8(*(const u32x4*)(proj + (rowbase + t0 - 1) * 4096 + 3072 + c0), ca);
#pragma unroll
            for (int e = 0; e < 8; ++e) vm1[e] = xa[e] * ca[e];
        } else {
#pragma unroll
            for (int e = 0; e < 8; ++e) { vm2[e] = 0.f; vm1[e] = 0.f; }
        }
        for (int tt = 0; tt < 16; ++tt) {
            const size_t row = rowbase + t0 + tt;
            float xb[8], cgt[8], bg[8], gb[8];
            unpack8(*(const u32x4*)(proj + row * 4096 + 2048 + c0), xb); unpack8(*(const u32x4*)(proj + row * 4096 + 2560 + c0), bg);
            unpack8(*(const u32x4*)(proj + row * 4096 + 3072 + c0), cgt); unpack8(*(const u32x4*)(proj + row * 4096 + 3584 + c0), gb);
            float y[8];
#pragma unroll
            for (int e = 0; e < 8; ++e) { const float v = cgt[e] * xb[e]; const float uu = w[0][e] * vm2[e] + w[1][e] * vm1[e] + w[2][e] * v;
                y[e] = bg[e] * uu * (gb[e] * sigmoidf_(gb[e])); vm2[e] = vm1[e]; vm1[e] = v; }
            *(u32x4*)(ymix + row * 1536 + 1024 + c0) = pack8(y);
        }
        if ((rb & 511) == 511) { float* o = a.out + O_CBP + (size_t)seq * 2 * 512 + c0;
#pragma unroll
            for (int e = 0; e < 8; ++e) { o[e] = vm2[e]; o[512 + e] = vm1[e]; } }
    }
    for (int it = tix; it < MS * 64; it += tn) {
        const int cg = it & 63, c0 = cg * 8, t = (it >> 6) & 15, seq = it >> 10;
        const size_t row = (size_t)MP + seq * 16 + t;
        float v[3][8];
#pragma unroll
        for (int k = 0; k < 3; ++k) { const int tr = t - 2 + k;
            if (tr >= 0) { float xa[8], ca[8]; unpack8(*(const u32x4*)(proj + (row - 2 + k) * 4096 + 2048 + c0), xa); unpack8(*(const u32x4*)(proj + (row - 2 + k) * 4096 + 3072 + c0), ca);
#pragma unroll
                for (int e = 0; e < 8; ++e) v[k][e] = xa[e] * ca[e]; }
            else {
#pragma unroll
                for (int e = 0; e < 8; ++e) v[k][e] = a.cache_b[((size_t)seq * 2 + (2 + tr)) * 512 + c0 + e]; } }
        float bg[8], gb[8], y[8];
        unpack8(*(const u32x4*)(proj + row * 4096 + 2560 + c0), bg); unpack8(*(const u32x4*)(proj + row * 4096 + 3584 + c0), gb);
#pragma unroll
        for (int e = 0; e < 8; ++e) { const float uu = a.w_conv_b[c0 + e] * v[0][e] + a.w_conv_b[512 + c0 + e] * v[1][e] + a.w_conv_b[1024 + c0 + e] * v[2][e];
            y[e] = bg[e] * uu * (gb[e] * sigmoidf_(gb[e])); }
        *(u32x4*)(ymix + row * 1536 + 1024 + c0) = pack8(y);
        if (t == 15) { float* o = a.out + O_CBS + (size_t)seq * 2 * 512 + c0;
#pragma unroll
            for (int e = 0; e < 8; ++e) { o[e] = v[1][e]; o[512 + e] = v[2][e]; } }
    }
}

__device__ void p5_final(const Args& a) {
    const int lane = threadIdx.x & 63, gw = blockIdx.x * NWV + (threadIdx.x >> 6), nw = gridDim.x * NWV;
    const float* rss = (const float*)(a.ws + WS_RSS);
    for (int row = gw; row < MT; row += nw) {
        float* yr = a.out + (size_t)row * 1024;
        float ss = lane < 16 ? rss[(size_t)row * 16 + lane] : 0.f;
#pragma unroll
        for (int o = 1; o < 16; o <<= 1) ss += __shfl_xor(ss, o);
        ss = __shfl(ss, 0);
        const float rinv = rsqrtf(ss * (1.f / 1024.f) + 1e-6f);
#pragma unroll
        for (int i = 0; i < 4; ++i) { const int c = (i * 64 + lane) * 4;
            const f32x4 v = *(const f32x4*)(yr + c), g = *(const f32x4*)(a.g_final + c);
            *(f32x4*)(yr + c) = (v * rinv) * g; }
    }
}


__device__ void p6_final(const Args& a) {
    const int lane = threadIdx.x & 63, gw = blockIdx.x * NWV + (threadIdx.x >> 6), nw = gridDim.x * NWV;
    const float* ada = (const float*)(a.ws + WS_ADA); const bf16_t* om = (const bf16_t*)(a.ws + WS_OM);
    for (int rowa = gw; rowa < MT; rowa += 2 * nw) {
        const int nr = (rowa + nw < MT) ? 2 : 1;
        f32x4 v[2][4]; uint2 w[2][4];
#pragma unroll
        for (int k = 0; k < 2; ++k) { const int row = (k < nr) ? rowa + k * nw : rowa;
            const float* xr = row < MP ? a.xp + (size_t)row * 1024 : a.xs + (size_t)(row - MP) * 1024;
#pragma unroll
            for (int i = 0; i < 4; ++i) { v[k][i] = *(const f32x4*)(xr + (i * 64 + lane) * 4); w[k][i] = *(const uint2*)(om + (size_t)row * 1024 + (i * 64 + lane) * 4); } }
        float ss[2] = {0.f, 0.f};
#pragma unroll
        for (int k = 0; k < 2; ++k) { const int row = (k < nr) ? rowa + k * nw : rowa;
            const int b = row < MP ? (row >> 13) : 8 + ((row - MP) >> 4);
#pragma unroll
            for (int i = 0; i < 4; ++i) { const f32x4 g = *(const f32x4*)(ada + (size_t)b * 3072 + 2048 + (i * 64 + lane) * 4);
                const f32x4 o = (f32x4){bf_lo(w[k][i].x), bf_hi(w[k][i].x), bf_lo(w[k][i].y), bf_hi(w[k][i].y)};
                v[k][i] = v[k][i] + g * o;
                ss[k] += v[k][i][0] * v[k][i][0] + v[k][i][1] * v[k][i][1] + v[k][i][2] * v[k][i][2] + v[k][i][3] * v[k][i][3]; }
#pragma unroll
            for (int o = 1; o < 64; o <<= 1) ss[k] += __shfl_xor(ss[k], o); }
#pragma unroll
        for (int k = 0; k < 2; ++k) { if (k < nr) { const int row = rowa + k * nw;
            const float rinv = rsqrtf(ss[k] * (1.f / 1024.f) + 1e-6f);
            float* yr = a.out + (size_t)row * 1024;
#pragma unroll
            for (int i = 0; i < 4; ++i) { const int c = (i * 64 + lane) * 4; const f32x4 g = *(const f32x4*)(a.g_final + c);
                *(f32x4*)(yr + c) = (v[k][i] * rinv) * g; } } }
    }
}

__global__ void __launch_bounds__(NTHR, 2) mega_fwd(Args a) {
    extern __shared__ __attribute__((aligned(16))) unsigned char lds_raw[];
    LAS unsigned char* lds = (LAS unsigned char*)lds_raw;
    cg::grid_group grid = cg::this_grid();
    const int lo = a.ph_lo, hi = a.ph_hi;
    if (hi > 1000) grid.sync();
    if (threadIdx.x < 4) ((LAS unsigned*)(lds + pg8::STAGE_BYTES))[threadIdx.x] = 0u;
    __syncthreads();
    XcdBarrier bar = xcd_barrier_post((unsigned*)(a.ws + WS_BAR), (volatile LAS unsigned*)(lds + pg8::STAGE_BYTES));
#define IN(k) (lo <= (k) && (k) < hi)
#define SEAM(k) do { if (IN(k) && IN((k) + 1)) xcd_barrier(bar); } while (0)
    if (IN(0)) p0_prologue(a, lds);
    SEAM(0);
    if (IN(1)) p1_norm(a);
    SEAM(1);
    if (IN(2)) { pg8::Gemm g{(const bf16_t*)(a.ws + WS_HN), (const bf16_t*)(a.ws + WS_BT1), MT, 4096, 1024}; pg8::StaticOrder S; S.init(MT, 4096, (int)gridDim.x, (int)blockIdx.x);
        pg8::EpiBf16 E{(bf16_t*)(a.ws + WS_PROJ), 4096};
        pg8::gemm_phase<pg8::EpiBf16, pg8::StaticOrder, false>(lds, g, S, E, nullptr); }
    SEAM(2);
    if (IN(3)) {
        if (threadIdx.x < 256) p3_mixer_a1(a, lds, (int)blockIdx.x * 4 + (int)(threadIdx.x >> 6), (int)gridDim.x * 4);
        else p3_mixer_b(a, (int)blockIdx.x * 256 + (int)threadIdx.x - 256, (int)gridDim.x * 256); }
    SEAM(3);
    if (IN(4)) p4_mixer_a2(a);
    SEAM(4);
    if (IN(5)) { pg8::Gemm g{(const bf16_t*)(a.ws + WS_YMIX), (const bf16_t*)(a.ws + WS_BT2), MT, 1024, 1536}; pg8::StaticOrder S; S.init(MT, 1024, (int)gridDim.x, (int)blockIdx.x);
        pg8::EpiBf16 E{(bf16_t*)(a.ws + WS_OM), 1024};
        pg8::gemm_phase<pg8::EpiBf16, pg8::StaticOrder, false>(lds, g, S, E, nullptr); }
    SEAM(5);
    if (IN(6)) p6_final(a);
#undef IN
#undef SEAM
}

#ifndef N_LAUNCHES
#define N_LAUNCHES 1
#endif
constexpr int NPH = 7, LDS_BYTES = pg8::STAGE_BYTES + 16;

extern "C" void kernel_launch(void* const* d_in, const int* in_sizes, int n_in, void* d_out, int out_size, void* d_ws, size_t ws_size, hipStream_t stream) {
    static int grid = 0;
    if (grid == 0) {
        if (n_in != 21 || (size_t)out_size != O_END || ws_size < WS_END) { fprintf(stderr, "kernel_launch: unexpected shapes (n_in %d out %d ws %zu need %zu)\n", n_in, out_size, ws_size, (size_t)WS_END); grid = -1; return; }
        int dev = 0, cus = 0, per_cu = 0;
        hipGetDevice(&dev); hipDeviceGetAttribute(&cus, hipDeviceAttributeMultiprocessorCount, dev);
        if (hipFuncSetAttribute((const void*)mega_fwd, hipFuncAttributeMaxDynamicSharedMemorySize, LDS_BYTES) != hipSuccess) { fprintf(stderr, "kernel_launch: hipFuncSetAttribute failed\n"); grid = -1; return; }
        if (hipOccupancyMaxActiveBlocksPerMultiprocessor(&per_cu, (const void*)mega_fwd, NTHR, LDS_BYTES) != hipSuccess || per_cu < 1) { fprintf(stderr, "kernel_launch: occupancy query says %d\n", per_cu); per_cu = 1; }
        (void)hipGetLastError();
        grid = cus * 1;
    }
    if (grid < 0) return;
    if (hipMemsetAsync((char*)d_ws + WS_BAR, 0, XCD_BAR_WORDS * 4, stream) != hipSuccess) { fprintf(stderr, "kernel_launch: memset failed\n"); return; }
    Args a{};
    const float** ip = (const float**)&a;
    for (int i = 0; i < 21; ++i) ip[i] = (const float*)d_in[i];
    a.out = (float*)d_out; a.ws = (unsigned char*)d_ws;
#if N_LAUNCHES == 1
    a.ph_lo = 0; a.ph_hi = NPH;
    void* args[] = {&a};
    hipError_t e = hipLaunchCooperativeKernel((const void*)mega_fwd, dim3(grid), dim3(NTHR), args, LDS_BYTES, stream);
    if (e != hipSuccess) fprintf(stderr, "cooperative launch failed: %s (grid %d)\n", hipGetErrorString(e), grid);
#else
    for (int ph = 0; ph < NPH; ++ph) { a.ph_lo = ph; a.ph_hi = ph + 1; hipLaunchKernelGGL(mega_fwd, dim3(grid), dim3(NTHR), LDS_BYTES, stream, a); }
#endif
}
```

```cpp
#include <hip/hip_cooperative_groups.h>
#include <cstdio>
#include <cstdint>
namespace cg = cooperative_groups;
#include <hip/hip_runtime.h>
namespace pg8 {
#define PG8_LAS __attribute__((address_space(3)))
typedef unsigned short bf16_t;
typedef short bf16x8 __attribute__((ext_vector_type(8)));
typedef float f32x4 __attribute__((ext_vector_type(4)));
typedef unsigned u32x4 __attribute__((ext_vector_type(4)));
constexpr int BM = 256, BK = 64, HALF = 128, HTB = HALF * BK * 2  , STAGE_BYTES = 8 * HTB, NXCD = 8, WGM = 8;

__host__ __device__ __forceinline__ int lds_byte(int r, int c) { const int st = (r >> 4) * 2 + (c >> 5), rr = r & 15, cc = c & 31, ob = rr * 64 + cc * 2; return st * 1024 + (ob ^ (((ob >> 9) & 1) << 5)); }
__host__ __device__ __forceinline__ void stage_rc(int b, int& R, int& C) { const int st = b / 1024, sb = b % 1024, swz = sb ^ (((sb >> 9) & 1) << 5); R = (st >> 1) * 16 + swz / 64; C = (st & 1) * 32 + (swz % 64) / 2; }
__host__ __device__ __forceinline__ int perm32(int rho) { const int n = rho >> 4, i = rho & 15; return 8 * (i >> 2) + 4 * n + (i & 3); }

struct Unit { int pm, pn; };
struct Gemm { const bf16_t* A; const bf16_t* Bt; int M, N, K; };

struct StaticOrder {
    int nM, nN, nwg, G, c;
    __host__ __device__ void init(int M, int N, int G_, int c_) { nM = M / BM; nN = N / BM; nwg = nM * nN; G = G_; c = c_; }
    __host__ __device__ bool next(int i, Unit& u) const {
        const long L = (long)i * G + c; if (L >= nwg) return false;
        int wgid = (int)L; { const int q = nwg / NXCD, r = nwg % NXCD, xcd = wgid % NXCD, off = wgid / NXCD; wgid = (xcd < r ? xcd * (q + 1) : r * (q + 1) + (xcd - r) * q) + off; }
        const int nig = WGM * nN, gid = wgid / nig, fm = gid * WGM, gsz = (nM - fm) < WGM ? (nM - fm) : WGM;
        u.pm = fm + ((wgid % nig) % gsz); u.pn = (wgid % nig) / gsz; return true;
    }
    __device__ __forceinline__ void a_ready(const Unit&) const {}
    __device__ __forceinline__ void done(const Unit&) const {}
};
__device__ __forceinline__ unsigned cvt_pk_bf16(float lo, float hi) { unsigned r; asm volatile("v_cvt_pk_bf16_f32 %0, %1, %2" : "=v"(r) : "v"(lo), "v"(hi)); return r; }
struct EpiBf16 {
    static constexpr bool PERM = true, AFTER_DRAIN = false;
    bf16_t* O; int ldc;
    __device__ __forceinline__ void operator()(const f32x4 (&acc)[2][2][4][2], const Unit& u, int wr, int wc, int fr, int fq) const {
        const int row0 = u.pm * BM + wr * 64 + fr; const int col0 = u.pn * BM + wc * 32 + 8 * fq;
#pragma unroll
        for (int ai = 0; ai < 2; ++ai)
#pragma unroll
            for (int m = 0; m < 4; ++m) { bf16_t* rowp = O + (size_t)(row0 + ai * HALF + m * 16) * ldc + col0;
#pragma unroll
                for (int bj = 0; bj < 2; ++bj) { const f32x4 v0 = acc[ai][bj][m][0], v1 = acc[ai][bj][m][1];
                    u32x4 w; w.x = cvt_pk_bf16(v0[0], v0[1]); w.y = cvt_pk_bf16(v0[2], v0[3]); w.z = cvt_pk_bf16(v1[0], v1[1]); w.w = cvt_pk_bf16(v1[2], v1[3]);
                    *(u32x4*)(rowp + bj * HALF) = w; } }
    }
};
struct EpiRes {
    static constexpr bool PERM = false, AFTER_DRAIN = false;
    const float* xp; const float* xs; const float* ada; float* out; float* rss;
    __device__ __forceinline__ void operator()(const f32x4 (&acc)[2][2][4][2], const Unit& u, int wr, int wc, int fr, int fq) const {
        const int col0 = u.pn * BM + wc * 32 + 4 * fq;
#pragma unroll
        for (int ai = 0; ai < 2; ++ai)
#pragma unroll
            for (int m = 0; m < 4; ++m) {
                const int row = u.pm * BM + ai * HALF + wr * 64 + m * 16 + fr;
                const float* xr = row < 65536 ? xp + (size_t)row * 1024 : xs + (size_t)(row - 65536) * 1024;
                const int b = row < 65536 ? (row >> 13) : 8 + ((row - 65536) >> 4);
                const float* gr = ada + (size_t)b * 3072 + 2048;
                float* orow = out + (size_t)row * 1024;
                float s = 0.f;
#pragma unroll
                for (int bj = 0; bj < 2; ++bj)
#pragma unroll
                    for (int n = 0; n < 2; ++n) { const int c = col0 + bj * HALF + n * 16;
                        const f32x4 xv = *(const f32x4*)(xr + c), gv = *(const f32x4*)(gr + c);
                        const f32x4 o = xv + gv * acc[ai][bj][m][n];
                        *(f32x4*)(orow + c) = o; s += o[0] * o[0] + o[1] * o[1] + o[2] * o[2] + o[3] * o[3]; }
                s += __shfl_xor(s, 16); s += __shfl_xor(s, 32);
                if (fq == 0) rss[(size_t)row * 16 + u.pn * 4 + wc] = s;
            }
    }
};

struct EpiResNorm {
    static constexpr bool PERM = false, AFTER_DRAIN = false;
    const float* xp; const float* xs; const float* ada; const float* gfin; float* out; float* xbuf; unsigned* cnt;
    __device__ __forceinline__ void operator()(f32x4 (&acc)[2][2][4][2], const Unit& u, int wr, int wc, int fr, int fq) const {
        const int col0 = u.pn * BM + wc * 32 + 4 * fq;
#pragma unroll
        for (int ai = 0; ai < 2; ++ai)
#pragma unroll
            for (int m = 0; m < 4; ++m) {
                const int row = u.pm * BM + ai * HALF + wr * 64 + m * 16 + fr;
                const float* xr = row < 65536 ? xp + (size_t)row * 1024 : xs + (size_t)(row - 65536) * 1024;
                const int b = row < 65536 ? (row >> 13) : 8 + ((row - 65536) >> 4);
                const float* gr = ada + (size_t)b * 3072 + 2048;
                float s = 0.f;
#pragma unroll
                for (int bj = 0; bj < 2; ++bj)
#pragma unroll
                    for (int n = 0; n < 2; ++n) { const int c = col0 + bj * HALF + n * 16;
                        const f32x4 xv = *(const f32x4*)(xr + c), gv = *(const f32x4*)(gr + c);
                        const f32x4 o = xv + gv * acc[ai][bj][m][n];
                        acc[ai][bj][m][n] = o; s += o[0] * o[0] + o[1] * o[1] + o[2] * o[2] + o[3] * o[3]; }
                s += __shfl_xor(s, 16); s += __shfl_xor(s, 32);
                if (fq == 0) __hip_atomic_store(xbuf + (size_t)row * 16 + u.pn * 4 + wc, s, __ATOMIC_RELAXED, __HIP_MEMORY_SCOPE_AGENT);
            }
        asm volatile("s_waitcnt vmcnt(0)" ::: "memory");
        unsigned* c = cnt + (size_t)(u.pm * 2 + wr) * 64;
        if (fr == 0 && fq == 0) __hip_atomic_fetch_add(c, 1u, __ATOMIC_RELAXED, __HIP_MEMORY_SCOPE_AGENT);
        { const unsigned long long t0 = __builtin_amdgcn_s_memrealtime();
          while ((unsigned)__builtin_amdgcn_readfirstlane(__hip_atomic_load(c, __ATOMIC_RELAXED, __HIP_MEMORY_SCOPE_AGENT)) < 16u) {
              if (__builtin_amdgcn_s_memrealtime() - t0 > 4000000ull) break;
              __builtin_amdgcn_s_sleep(2); } }
        asm volatile("" ::: "memory");
#pragma unroll
        for (int ai = 0; ai < 2; ++ai)
#pragma unroll
            for (int m = 0; m < 4; ++m) {
                const int row = u.pm * BM + ai * HALF + wr * 64 + m * 16 + fr;
                const float* xb = xbuf + (size_t)row * 16 + fq * 4;
                float t = (__hip_atomic_load(xb, __ATOMIC_RELAXED, __HIP_MEMORY_SCOPE_AGENT) + __hip_atomic_load(xb + 1, __ATOMIC_RELAXED, __HIP_MEMORY_SCOPE_AGENT))
                        + (__hip_atomic_load(xb + 2, __ATOMIC_RELAXED, __HIP_MEMORY_SCOPE_AGENT) + __hip_atomic_load(xb + 3, __ATOMIC_RELAXED, __HIP_MEMORY_SCOPE_AGENT));
                t += __shfl_xor(t, 16); t += __shfl_xor(t, 32);
                const float rinv = rsqrtf(t * (1.f / 1024.f) + 1e-6f);
                float* orow = out + (size_t)row * 1024;
#pragma unroll
                for (int bj = 0; bj < 2; ++bj)
#pragma unroll
                    for (int n = 0; n < 2; ++n) { const int cc = col0 + bj * HALF + n * 16;
                        const f32x4 g = *(const f32x4*)(gfin + cc);
                        *(f32x4*)(orow + cc) = (acc[ai][bj][m][n] * rinv) * g; }
            }
    }
};
struct RowOrder {
    int G, c, nM;
    __host__ __device__ void init(int M, int G_, int c_) { nM = M / BM; G = G_; c = c_; }
    __host__ __device__ bool next(int i, Unit& u) const {
        int pslot, pn;
        if ((G & 31) == 0) { const int xcd = c & 7, slot = c >> 3; pslot = xcd * (G >> 5) + (slot >> 2); pn = slot & 3; }
        else { pslot = c >> 2; pn = c & 3; if (c >= (G & ~3)) return false; }
        const int pm = i * (G >> 2) + pslot; if (pm >= nM) return false;
        u.pm = pm; u.pn = pn; return true;
    }
    __device__ __forceinline__ void a_ready(const Unit&) const {}
    __device__ __forceinline__ void done(const Unit&) const {}
};

template <class Epi, class Sched, bool STAMP = false, bool ALIGN_EPI = true>
__device__ __forceinline__ void gemm_phase(PG8_LAS unsigned char* lds, const Gemm g, const Sched& S, const Epi& E, unsigned long long* stamps) {
    const int tid = threadIdx.x, wid = __builtin_amdgcn_readfirstlane(tid >> 6), lane = tid & 63, wr = wid >> 2, wc = wid & 3, fr = lane & 15, fq = lane >> 4;
    const int K = g.K, nt = K / BK;
    int ts_lo = 0, ts_hi = 0, nts = 0; const unsigned long long rt_entry = STAMP ? (unsigned long long)wall_clock64() : 0ull;
#define PG8_STAMP() do { if (STAMP && wid == 0 && nts < 64) { const unsigned long long _c = (unsigned long long)clock64(); \
        ts_lo = (lane == nts) ? (int)(unsigned)_c : ts_lo; ts_hi = (lane == nts) ? (int)(unsigned)(_c >> 32) : ts_hi; ++nts; } } while (0)
    PG8_STAMP();
    unsigned voffA[2], voffB[2];
#pragma unroll
    for (int i = 0; i < 2; ++i) { int R, C; stage_rc(tid * 16 + i * 8192, R, C); const int Rb = Epi::PERM ? ((R & ~31) + perm32(R & 31)) : R;
        voffA[i] = (unsigned)(R * K + C) * 2u; voffB[i] = (unsigned)(Rb * K + C) * 2u; }
    const size_t kstep = (size_t)(BK * 2);
    const size_t hstep = (size_t)HALF * K * 2;
    const size_t tstep = 2 * hstep;
    const unsigned ldsw = (unsigned)wid * 1024u;
    const int aoff = lds_byte(wr * 64 + fr, fq * 8), boff = lds_byte(wc * 32 + fr, fq * 8);
#define PG8_SA(b, h) (((b) * 2 + (h)) * HTB)
#define PG8_SB(b, h) ((4 + (b) * 2 + (h)) * HTB)
#define PG8_STAGE(bufoff, gbase, voff) do { _Pragma("unroll") for (int _i = 0; _i < 2; ++_i) \
        __builtin_amdgcn_global_load_lds((const unsigned*)((const char*)(gbase) + (voff)[_i]), (PG8_LAS unsigned*)(lds + (bufoff) + ldsw + _i * 8192), 16, 0, 0); } while (0)
#define PG8_LDA(dst, b, h) do { _Pragma("unroll") for (int m = 0; m < 4; ++m) _Pragma("unroll") for (int k = 0; k < 2; ++k) dst[m][k] = *(const PG8_LAS bf16x8*)(lds + PG8_SA(b, h) + aoff + m * 2048 + k * 1024); } while (0)
#define PG8_LDB(dst, b, h) do { _Pragma("unroll") for (int n = 0; n < 2; ++n) _Pragma("unroll") for (int k = 0; k < 2; ++k) dst[n][k] = *(const PG8_LAS bf16x8*)(lds + PG8_SB(b, h) + boff + n * 2048 + k * 1024); } while (0)
#define PG8_MMA(ai, bj, At, Bt) do { __builtin_amdgcn_s_setprio(1); _Pragma("unroll") for (int m = 0; m < 4; ++m) _Pragma("unroll") for (int n = 0; n < 2; ++n) _Pragma("unroll") for (int k = 0; k < 2; ++k) \
        acc[ai][bj][m][n] = __builtin_amdgcn_mfma_f32_16x16x32_bf16(Bt[n][k], At[m][k], acc[ai][bj][m][n], 0, 0, 0); __builtin_amdgcn_s_setprio(0); } while (0)
#define PG8_WAIT_V(n) asm volatile("s_waitcnt vmcnt(" #n ")" ::: "memory")
#define PG8_WAIT_L(n) asm volatile("s_waitcnt lgkmcnt(" #n ")" ::: "memory")
#define PG8_BAR __builtin_amdgcn_s_barrier()
#define PG8_SCHED __builtin_amdgcn_sched_barrier(0)
    Unit cur, nxt; int ui = 0;
    if (!S.next(0, cur)) return;
    f32x4 acc[2][2][4][2];
#pragma unroll
    for (int a = 0; a < 2; ++a)
#pragma unroll
        for (int b = 0; b < 2; ++b)
#pragma unroll
            for (int m = 0; m < 4; ++m)
#pragma unroll
                for (int n = 0; n < 2; ++n) acc[a][b][m][n] = (f32x4){0.f, 0.f, 0.f, 0.f};
    bf16x8 At[4][2], B0[2][2], B1[2][2];
    const char* cA = (const char*)g.A + (size_t)cur.pm * tstep; const char* cB = (const char*)g.Bt + (size_t)cur.pn * tstep;
    S.a_ready(cur);
    PG8_STAGE(PG8_SB(0, 0), cB, voffB); PG8_STAGE(PG8_SA(0, 0), cA, voffA); PG8_STAGE(PG8_SB(0, 1), cB + hstep, voffB); PG8_STAGE(PG8_SA(0, 1), cA + hstep, voffA);
    if (wr == 1) PG8_BAR;
    PG8_WAIT_V(4); PG8_BAR;
    PG8_STAGE(PG8_SB(1, 0), cB + kstep, voffB); PG8_STAGE(PG8_SA(1, 0), cA + kstep, voffA); PG8_STAGE(PG8_SB(1, 1), cB + hstep + kstep, voffB);
    PG8_WAIT_V(6); PG8_BAR;
    PG8_STAMP();
    for (;;) {
        const bool has_next = S.next(ui + 1, nxt);
        const char* nA = has_next ? (const char*)g.A + (size_t)nxt.pm * tstep : cA; const char* nB = has_next ? (const char*)g.Bt + (size_t)nxt.pn * tstep : cB;
        for (int t = 0; t < nt; t += 2) {
            const bool last = (t == nt - 2);
            const char* a1 = cA + (size_t)(t + 1) * kstep;
            const char* a2 = last ? nA : cA + (size_t)(t + 2) * kstep; const char* b2 = last ? nB : cB + (size_t)(t + 2) * kstep;
            const char* a3 = a2 + kstep; const char* b3 = b2 + kstep;
            if (last && has_next) S.a_ready(nxt);
            PG8_LDB(B0, 0, 0); PG8_SCHED; PG8_LDA(At, 0, 0); PG8_STAGE(PG8_SA(1, 1), a1 + hstep, voffA);
            PG8_WAIT_L(8); PG8_BAR; PG8_WAIT_L(0); PG8_MMA(0, 0, At, B0); PG8_BAR; PG8_SCHED;
            PG8_LDB(B1, 0, 1); PG8_STAGE(PG8_SB(0, 0), b2, voffB);
            PG8_BAR; PG8_WAIT_L(0); PG8_MMA(0, 1, At, B1); PG8_BAR;
            PG8_LDA(At, 0, 1); PG8_STAGE(PG8_SA(0, 0), a2, voffA);
            PG8_BAR; PG8_WAIT_L(0); PG8_MMA(1, 0, At, B0); PG8_BAR; PG8_SCHED;
            PG8_STAGE(PG8_SB(0, 1), b2 + hstep, voffB);
            PG8_WAIT_V(6); PG8_BAR; PG8_MMA(1, 1, At, B1); PG8_BAR;
            PG8_LDB(B0, 1, 0); PG8_SCHED; PG8_LDA(At, 1, 0); PG8_STAGE(PG8_SA(0, 1), a2 + hstep, voffA);
            PG8_WAIT_L(8); PG8_BAR; PG8_WAIT_L(0); PG8_MMA(0, 0, At, B0); PG8_BAR; PG8_SCHED;
            PG8_LDB(B1, 1, 1); PG8_STAGE(PG8_SB(1, 0), b3, voffB);
            PG8_BAR; PG8_WAIT_L(0); PG8_MMA(0, 1, At, B1); PG8_BAR;
            PG8_LDA(At, 1, 1); PG8_STAGE(PG8_SA(1, 0), a3, voffA);
            PG8_BAR; PG8_WAIT_L(0); PG8_MMA(1, 0, At, B0); PG8_BAR; PG8_SCHED;
            PG8_STAGE(PG8_SB(1, 1), b3 + hstep, voffB);
            PG8_WAIT_V(6); PG8_BAR; PG8_MMA(1, 1, At, B1); PG8_BAR;
        }
        PG8_STAMP();
        if constexpr (ALIGN_EPI) { if (wr == 0) PG8_BAR; }
        if constexpr (!Epi::AFTER_DRAIN) { E(acc, cur, wr, wc, fr, fq); S.done(cur); }
        PG8_STAMP();
        if (!has_next) break;
#pragma unroll
        for (int a = 0; a < 2; ++a)
#pragma unroll
            for (int b = 0; b < 2; ++b)
#pragma unroll
                for (int m = 0; m < 4; ++m)
#pragma unroll
                    for (int n = 0; n < 2; ++n) acc[a][b][m][n] = (f32x4){0.f, 0.f, 0.f, 0.f};
        cur = nxt; cA = nA; cB = nB; ++ui;
        if constexpr (ALIGN_EPI) { if (wr == 1) PG8_BAR; }
    }
    PG8_WAIT_V(0);
    if constexpr (!ALIGN_EPI) { if (wr == 0) PG8_BAR; }
    PG8_BAR;
    if constexpr (Epi::AFTER_DRAIN) { E.fused(acc, cur, wr, wc, fr, fq, lds, wid, lane); S.done(cur); }
    PG8_STAMP();
    if (STAMP && wid == 0) { stamps[lane] = lane < nts ? (((unsigned long long)(unsigned)ts_hi << 32) | (unsigned)ts_lo) : 0ull;
        if (lane == 62) stamps[62] = rt_entry; if (lane == 63) stamps[63] = (unsigned long long)wall_clock64(); }
#undef PG8_STAMP
#undef PG8_SA
#undef PG8_SB
#undef PG8_STAGE
#undef PG8_LDA
#undef PG8_LDB
#undef PG8_MMA
#undef PG8_WAIT_V
#undef PG8_WAIT_L
#undef PG8_BAR
#undef PG8_SCHED
}
template <class Epi, class Sched, bool ALIGN_EPI = false, bool SP2 = false>
__device__ __forceinline__ void gemm_phase_sp2(PG8_LAS unsigned char* lds, const Gemm g, const Sched& S, const Epi& E) {
    const int tid = threadIdx.x, wid = __builtin_amdgcn_readfirstlane(tid >> 6), lane = tid & 63, wr = wid >> 2, wc = wid & 3, fr = lane & 15, fq = lane >> 4;
    const int K = g.K, nt = K / BK;
    unsigned voffA[2], voffB[2];
#pragma unroll
    for (int i = 0; i < 2; ++i) { int R, C; stage_rc(tid * 16 + i * 8192, R, C); const int Rb = Epi::PERM ? ((R & ~31) + perm32(R & 31)) : R;
        voffA[i] = (unsigned)(R * K + C) * 2u; voffB[i] = (unsigned)(Rb * K + C) * 2u; }
    const size_t kstep = (size_t)(BK * 2);
    const size_t hstep = (size_t)HALF * K * 2;
    const size_t tstep = 2 * hstep;
    const unsigned ldsw = (unsigned)wid * 1024u;
    const int aoff = lds_byte(wr * 64 + fr, fq * 8), boff = lds_byte(wc * 32 + fr, fq * 8);
#define PG8_SA(b, h) (((b) * 2 + (h)) * HTB)
#define PG8_SB(b, h) ((4 + (b) * 2 + (h)) * HTB)
#define PG8_STAGE(bufoff, gbase, voff) do { _Pragma("unroll") for (int _i = 0; _i < 2; ++_i) \
        __builtin_amdgcn_global_load_lds((const unsigned*)((const char*)(gbase) + (voff)[_i]), (PG8_LAS unsigned*)(lds + (bufoff) + ldsw + _i * 8192), 16, 0, 0); } while (0)
#define PG8_LDA(dst, b, h) do { _Pragma("unroll") for (int m = 0; m < 4; ++m) _Pragma("unroll") for (int k = 0; k < 2; ++k) dst[m][k] = *(const PG8_LAS bf16x8*)(lds + PG8_SA(b, h) + aoff + m * 2048 + k * 1024); } while (0)
#define PG8_LDB(dst, b, h) do { _Pragma("unroll") for (int n = 0; n < 2; ++n) _Pragma("unroll") for (int k = 0; k < 2; ++k) dst[n][k] = *(const PG8_LAS bf16x8*)(lds + PG8_SB(b, h) + boff + n * 2048 + k * 1024); } while (0)
#define PG8_MMA(ai, bj, At, Bt) do { __builtin_amdgcn_s_setprio(1); _Pragma("unroll") for (int m = 0; m < 4; ++m) _Pragma("unroll") for (int n = 0; n < 2; ++n) _Pragma("unroll") for (int k = 0; k < 2; ++k) \
        acc[ai][bj][m][n] = __builtin_amdgcn_mfma_f32_16x16x32_bf16(Bt[n][k], At[m][k], acc[ai][bj][m][n], 0, 0, 0); __builtin_amdgcn_s_setprio(0); } while (0)
#define PG8_WAIT_V(n) asm volatile("s_waitcnt vmcnt(" #n ")" ::: "memory")
#define PG8_WAIT_L(n) asm volatile("s_waitcnt lgkmcnt(" #n ")" ::: "memory")
#define PG8_BAR __builtin_amdgcn_s_barrier()
#define PG8_SCHED __builtin_amdgcn_sched_barrier(0)
    Unit cur, nxt; int ui = 0;
    if (!S.next(0, cur)) return;
    f32x4 acc[2][2][4][2];
#pragma unroll
    for (int a = 0; a < 2; ++a)
#pragma unroll
        for (int b = 0; b < 2; ++b)
#pragma unroll
            for (int m = 0; m < 4; ++m)
#pragma unroll
                for (int n = 0; n < 2; ++n) acc[a][b][m][n] = (f32x4){0.f, 0.f, 0.f, 0.f};
    bf16x8 At[4][2], B0[2][2], B1[2][2];
    const char* cA = (const char*)g.A + (size_t)cur.pm * tstep; const char* cB = (const char*)g.Bt + (size_t)cur.pn * tstep;
    S.a_ready(cur);
    if constexpr (SP2) {
        PG8_STAGE(PG8_SB(0, 0), cB, voffB); PG8_STAGE(PG8_SB(0, 1), cB + hstep, voffB); PG8_STAGE(PG8_SA(0, 0), cA, voffA); PG8_STAGE(PG8_SA(0, 1), cA + hstep, voffA);
        if (wr == 1) PG8_BAR;
        PG8_WAIT_V(2); PG8_BAR;
        PG8_STAGE(PG8_SB(1, 0), cB + kstep, voffB); PG8_STAGE(PG8_SA(1, 0), cA + kstep, voffA); PG8_STAGE(PG8_SB(1, 1), cB + hstep + kstep, voffB);
        PG8_WAIT_V(6); PG8_BAR;
    } else {
        PG8_STAGE(PG8_SB(0, 0), cB, voffB); PG8_STAGE(PG8_SA(0, 0), cA, voffA); PG8_STAGE(PG8_SB(0, 1), cB + hstep, voffB); PG8_STAGE(PG8_SA(0, 1), cA + hstep, voffA);
        if (wr == 1) PG8_BAR;
        PG8_WAIT_V(4); PG8_BAR;
        PG8_STAGE(PG8_SB(1, 0), cB + kstep, voffB); PG8_STAGE(PG8_SA(1, 0), cA + kstep, voffA); PG8_STAGE(PG8_SB(1, 1), cB + hstep + kstep, voffB);
        PG8_WAIT_V(6); PG8_BAR;
    }
    for (;;) {
        const bool has_next = S.next(ui + 1, nxt);
        const char* nA = has_next ? (const char*)g.A + (size_t)nxt.pm * tstep : cA; const char* nB = has_next ? (const char*)g.Bt + (size_t)nxt.pn * tstep : cB;
        for (int t = 0; t < nt; t += 2) {
            const bool last = (t == nt - 2);
            const char* a1 = cA + (size_t)(t + 1) * kstep;
            const char* a2 = last ? nA : cA + (size_t)(t + 2) * kstep; const char* b2 = last ? nB : cB + (size_t)(t + 2) * kstep;
            const char* a3 = a2 + kstep; const char* b3 = b2 + kstep;
            if (last && has_next) S.a_ready(nxt);
            if constexpr (SP2) {
            PG8_LDB(B0, 0, 0); PG8_LDB(B1, 0, 1); PG8_SCHED; PG8_LDA(At, 0, 0); PG8_STAGE(PG8_SA(1, 1), a1 + hstep, voffA);
            PG8_WAIT_V(8); PG8_WAIT_L(0); PG8_BAR; PG8_MMA(0, 0, At, B0); PG8_MMA(0, 1, At, B1); PG8_BAR; PG8_SCHED;
            PG8_LDA(At, 0, 1); PG8_STAGE(PG8_SB(0, 0), b2, voffB); PG8_STAGE(PG8_SB(0, 1), b2 + hstep, voffB); PG8_STAGE(PG8_SA(0, 0), a2, voffA);
            PG8_WAIT_V(8); PG8_WAIT_L(0); PG8_BAR; PG8_MMA(1, 0, At, B0); PG8_MMA(1, 1, At, B1); PG8_BAR; PG8_SCHED;
            PG8_LDB(B0, 1, 0); PG8_LDB(B1, 1, 1); PG8_SCHED; PG8_LDA(At, 1, 0); PG8_STAGE(PG8_SA(0, 1), a2 + hstep, voffA);
            PG8_WAIT_V(8); PG8_WAIT_L(0); PG8_BAR; PG8_MMA(0, 0, At, B0); PG8_MMA(0, 1, At, B1); PG8_BAR; PG8_SCHED;
            PG8_LDA(At, 1, 1); PG8_STAGE(PG8_SB(1, 0), b3, voffB); PG8_STAGE(PG8_SB(1, 1), b3 + hstep, voffB); PG8_STAGE(PG8_SA(1, 0), a3, voffA);
            PG8_WAIT_V(8); PG8_WAIT_L(0); PG8_BAR; PG8_MMA(1, 0, At, B0); PG8_MMA(1, 1, At, B1); PG8_BAR; PG8_SCHED;
            } else {
            PG8_LDB(B0, 0, 0); PG8_SCHED; PG8_LDA(At, 0, 0); PG8_STAGE(PG8_SA(1, 1), a1 + hstep, voffA);
            PG8_WAIT_L(8); PG8_BAR; PG8_WAIT_L(0); PG8_MMA(0, 0, At, B0); PG8_BAR; PG8_SCHED;
            PG8_LDB(B1, 0, 1); PG8_STAGE(PG8_SB(0, 0), b2, voffB);
            PG8_BAR; PG8_WAIT_L(0); PG8_MMA(0, 1, At, B1); PG8_BAR;
            PG8_LDA(At, 0, 1); PG8_STAGE(PG8_SA(0, 0), a2, voffA);
            PG8_BAR; PG8_WAIT_L(0); PG8_MMA(1, 0, At, B0); PG8_BAR; PG8_SCHED;
            PG8_STAGE(PG8_SB(0, 1), b2 + hstep, voffB);
            PG8_WAIT_V(6); PG8_BAR; PG8_MMA(1, 1, At, B1); PG8_BAR;
            PG8_LDB(B0, 1, 0); PG8_SCHED; PG8_LDA(At, 1, 0); PG8_STAGE(PG8_SA(0, 1), a2 + hstep, voffA);
            PG8_WAIT_L(8); PG8_BAR; PG8_WAIT_L(0); PG8_MMA(0, 0, At, B0); PG8_BAR; PG8_SCHED;
            PG8_LDB(B1, 1, 1); PG8_STAGE(PG8_SB(1, 0), b3, voffB);
            PG8_BAR; PG8_WAIT_L(0); PG8_MMA(0, 1, At, B1); PG8_BAR;
            PG8_LDA(At, 1, 1); PG8_STAGE(PG8_SA(1, 0), a3, voffA);
            PG8_BAR; PG8_WAIT_L(0); PG8_MMA(1, 0, At, B0); PG8_BAR; PG8_SCHED;
            PG8_STAGE(PG8_SB(1, 1), b3 + hstep, voffB);
            PG8_WAIT_V(6); PG8_BAR; PG8_MMA(1, 1, At, B1); PG8_BAR;
            }
        }
        if constexpr (ALIGN_EPI) { if (wr == 0) PG8_BAR; }
        if constexpr (!Epi::AFTER_DRAIN) { E(acc, cur, wr, wc, fr, fq); S.done(cur); }
        if (!has_next) break;
#pragma unroll
        for (int a = 0; a < 2; ++a)
#pragma unroll
            for (int b = 0; b < 2; ++b)
#pragma unroll
                for (int m = 0; m < 4; ++m)
#pragma unroll
                    for (int n = 0; n < 2; ++n) acc[a][b][m][n] = (f32x4){0.f, 0.f, 0.f, 0.f};
        cur = nxt; cA = nA; cB = nB; ++ui;
        if constexpr (ALIGN_EPI) { if (wr == 1) PG8_BAR; }
    }
    PG8_WAIT_V(0);
    if constexpr (!ALIGN_EPI) { if (wr == 0) PG8_BAR; }
    PG8_BAR;
    if constexpr (Epi::AFTER_DRAIN) { E.fused(acc, cur, wr, wc, fr, fq, lds, wid, lane); S.done(cur); }
#undef PG8_SA
#undef PG8_SB
#undef PG8_STAGE
#undef PG8_LDA
#undef PG8_LDB
#undef PG8_MMA
#undef PG8_WAIT_V
#undef PG8_WAIT_L
#undef PG8_BAR
#undef PG8_SCHED
}

}
#define LAS __attribute__((address_space(3)))
#define XB_TMO      128
#define XB_XCNT(j)  (256  + 64 * (j))
#define XB_XSUB(j)  (1280 + 64 * (j))
#define XB_XGEN(j)  (2304 + 64 * (j))
#define XB_TOP      3328
#define XB_TOPGEN   3392
#define XCD_BAR_WORDS 3456
#define XB_SPIN_CAP (1u << 18)
typedef unsigned short bf16_t;
typedef short bf16x8 __attribute__((ext_vector_type(8)));
typedef float f32x4 __attribute__((ext_vector_type(4)));
typedef unsigned u32x4 __attribute__((ext_vector_type(4)));

constexpr int MP = 65536, MS = 512, MT = 66048;
constexpr int NTHR = 512, NWV = 8;
constexpr size_t al256(size_t x) { return (x + 255) & ~(size_t)255; }
constexpr size_t WS_ADA  = 0;
constexpr size_t WS_BT1  = al256(WS_ADA + 40 * 3072 * 4);
constexpr size_t WS_BT2  = al256(WS_BT1 + (size_t)4096 * 1024 * 2);
constexpr size_t WS_WG   = al256(WS_BT2 + (size_t)1024 * 1536 * 2);
constexpr size_t WS_AGG  = al256(WS_WG + 131072 * 2);
constexpr size_t WS_BAR  = al256(WS_AGG + (size_t)8 * 16 * 1024 * 2 * 4);
constexpr size_t WS_CNT  = al256(WS_BAR + XCD_BAR_WORDS * 4);
constexpr size_t WS_RSS  = al256(WS_CNT + (size_t)258 * 2 * 256);
constexpr size_t WS_HN   = al256(WS_RSS + (size_t)MT * 16 * 4);
constexpr size_t WS_LB   = WS_HN;
constexpr size_t WS_PROJ = al256(WS_HN + (size_t)MT * 1024 * 4);
constexpr size_t WS_YMIX = al256(WS_PROJ + (size_t)MT * 4096 * 2);
constexpr size_t WS_OM   = WS_HN;
constexpr size_t WS_END  = al256(WS_YMIX + (size_t)MT * 1536 * 2);
constexpr size_t O_Y = 0, O_CAP = (size_t)MT * 1024, O_LRP = O_CAP + 8 * 3 * 1024, O_CBP = O_LRP + 8 * 1024, O_CAS = O_CBP + 8 * 2 * 512,
                 O_LRS = O_CAS + 32 * 3 * 1024, O_CBS = O_LRS + 32 * 1024, O_END = O_CBS + 32 * 2 * 512;

struct Args {
    const float *xp, *xs, *cp, *cs, *cache_a, *state, *cache_b, *g_norm, *w_ada, *b_ada, *w_in, *w_conv_a, *b_conv_a, *w_rg, *b_rg, *w_ig, *b_ig, *lam, *w_conv_b, *w_out, *g_final;
    float* out; unsigned char* ws; int ph_lo, ph_hi;
};

__device__ __forceinline__ float bf_lo(unsigned u) { return __uint_as_float(u << 16); }
__device__ __forceinline__ float bf_hi(unsigned u) { return __uint_as_float(u & 0xffff0000u); }
__device__ __forceinline__ void unpack8(const u32x4 v, float* f) { f[0] = bf_lo(v.x); f[1] = bf_hi(v.x); f[2] = bf_lo(v.y); f[3] = bf_hi(v.y); f[4] = bf_lo(v.z); f[5] = bf_hi(v.z); f[6] = bf_lo(v.w); f[7] = bf_hi(v.w); }
__device__ __forceinline__ u32x4 pack8(const float* f) { u32x4 w; w.x = pg8::cvt_pk_bf16(f[0], f[1]); w.y = pg8::cvt_pk_bf16(f[2], f[3]); w.z = pg8::cvt_pk_bf16(f[4], f[5]); w.w = pg8::cvt_pk_bf16(f[6], f[7]); return w; }
__device__ __forceinline__ float sigmoidf_(float x) { return __builtin_amdgcn_rcpf(1.f + __builtin_amdgcn_exp2f(-1.44269504f * x)); }
template <int CTRL> __device__ __forceinline__ float dpp_keep(float old, float src) { return __int_as_float(__builtin_amdgcn_update_dpp(__float_as_int(old), __float_as_int(src), CTRL, 0xF, 0xF, false)); }


__device__ __forceinline__ unsigned xb_ld(unsigned* p)              { return __hip_atomic_load(p, __ATOMIC_RELAXED, __HIP_MEMORY_SCOPE_AGENT); }
__device__ __forceinline__ unsigned xb_add(unsigned* p, unsigned v) { return __hip_atomic_fetch_add(p, v, __ATOMIC_RELAXED, __HIP_MEMORY_SCOPE_AGENT); }
__device__ __forceinline__ unsigned xb_xcc_id() { return (unsigned)__builtin_amdgcn_s_getreg((3 << 11) | 20) & 0xFu; }
#define XB_SPIN(cond, bar) do { unsigned _sp = 0; while (cond) { __builtin_amdgcn_s_sleep(1); \
    if ((++_sp & 255u) == 0u) { if (xb_ld(&(bar)[XB_TMO])) break; if (_sp > XB_SPIN_CAP) { atomicAdd(&(bar)[XB_TMO], 1u); break; } } } } while (0)
struct XcdBarrier {
    unsigned* bar; unsigned x;
    volatile LAS unsigned* st;
};

__device__ __forceinline__ XcdBarrier xcd_barrier_post(unsigned* bar, volatile LAS unsigned* st) {
    XcdBarrier b; b.bar = bar; b.x = xb_xcc_id(); b.st = st;
    if (threadIdx.x == 0) (void)xb_add(&bar[XB_XCNT(b.x)], 1u);
    return b;
}
__device__ __forceinline__ void xcd_barrier_complete(unsigned* bar, unsigned x, unsigned& nloc, unsigned& nx) {
    const unsigned G = gridDim.x * gridDim.y * gridDim.z;
    unsigned sum, cnt, mine, sp = 0u;
    for (;;) {
        sum = 0u; cnt = 0u; mine = 0u;
#pragma unroll
        for (unsigned j = 0; j < 16; ++j) { const unsigned c = xb_ld(&bar[XB_XCNT(j)]); sum += c; cnt += (c > 0u) ? 1u : 0u; mine = (j == x) ? c : mine; }
        if (sum == G) break;
        __builtin_amdgcn_s_sleep(1);
        if ((++sp & 255u) == 0u) { if (xb_ld(&bar[XB_TMO])) break; if (sp > XB_SPIN_CAP) { atomicAdd(&bar[XB_TMO], 1u); break; } }
    }
    nloc = mine > 0u ? mine : 1u; nx = cnt > 0u ? cnt : 1u;
}

__device__ __forceinline__ void xcd_barrier(const XcdBarrier& b) {
    asm volatile("s_waitcnt vmcnt(0)" ::: "memory");
    __syncthreads();
    if (threadIdx.x == 0) {
        unsigned* bar = b.bar;
        __builtin_amdgcn_s_waitcnt(0);
        unsigned nloc = b.st[0], nx = b.st[1];
        if (nloc == 0u) { xcd_barrier_complete(bar, b.x, nloc, nx); b.st[0] = nloc; b.st[1] = nx; }
        const unsigned old = xb_add(&bar[XB_XSUB(b.x)], 1u);
        const unsigned gen = old / nloc;
        if (old + 1u == (gen + 1u) * nloc) {
            __builtin_amdgcn_fence(__ATOMIC_RELEASE, "agent");
            asm volatile("s_waitcnt vmcnt(0)" ::: "memory");
            const unsigned og = xb_add(&bar[XB_TOP], 1u);
            const unsigned tg = og / nx;
            if (og + 1u == (tg + 1u) * nx) xb_add(&bar[XB_TOPGEN], 1u);
            else XB_SPIN(xb_ld(&bar[XB_TOPGEN]) == tg, bar);
            __builtin_amdgcn_fence(__ATOMIC_ACQUIRE, "agent");
            xb_add(&bar[XB_XGEN(b.x)], 1u);
            asm volatile("s_waitcnt vmcnt(0)" ::: "memory");
        } else {
            XB_SPIN(xb_ld(&bar[XB_XGEN(b.x)]) == gen, bar);
            __builtin_amdgcn_fence(__ATOMIC_ACQUIRE, "agent");
            asm volatile("s_waitcnt vmcnt(0)" ::: "memory");
        }
    }
    __syncthreads();
}

#define XB_REC_WORDS 32

__device__ __forceinline__ void scan4(float& a0, float& a1, float& a2, float& a3, float& b0, float& b1, float& b2, float& b3, float h0, float h1, float h2, float h3) {
#define DPPM " row_mask:0xf bank_mask:0xf\n\t"
#define STEP(N) "v_fmac_f32_dpp %4, %4, %0 row_shr:" #N DPPM "v_fmac_f32_dpp %5, %5, %1 row_shr:" #N DPPM "v_fmac_f32_dpp %6, %6, %2 row_shr:" #N DPPM "v_fmac_f32_dpp %7, %7, %3 row_shr:" #N DPPM \
                "v_mul_f32_dpp %0, %0, %0 row_shr:" #N DPPM "v_mul_f32_dpp %1, %1, %1 row_shr:" #N DPPM "v_mul_f32_dpp %2, %2, %2 row_shr:" #N DPPM "v_mul_f32_dpp %3, %3, %3 row_shr:" #N DPPM
    asm volatile("s_nop 1\n\t"
        "v_fmac_f32_dpp %4, %8, %0 row_ror:1" DPPM "v_fmac_f32_dpp %5, %9, %1 row_ror:1" DPPM "v_fmac_f32_dpp %6, %10, %2 row_ror:1" DPPM "v_fmac_f32_dpp %7, %11, %3 row_ror:1" DPPM
        STEP(1) STEP(2) STEP(4) STEP(8)
        : "+v"(a0), "+v"(a1), "+v"(a2), "+v"(a3), "+v"(b0), "+v"(b1), "+v"(b2), "+v"(b3) : "v"(h0), "v"(h1), "v"(h2), "v"(h3));
#undef STEP
#undef DPPM
}

__device__ void p0_prologue(const Args& a, LAS unsigned char* lds) {
    const int tid = threadIdx.x, bx = blockIdx.x, G = gridDim.x;
    float* ada = (float*)(a.ws + WS_ADA);
    { unsigned* cz = (unsigned*)(a.ws + WS_CNT); for (int i = bx * NTHR + tid; i < 258 * 2 * 64; i += G * NTHR) cz[i] = 0u; }
    for (int it = bx; it < 192; it += G) {
        LAS float* sS = (LAS float*)lds; LAS float* red = (LAS float*)(lds + 40 * 256 * 4);
        const int n0 = it * 16, kq = tid >> 4, col = tid & 15;
        float acc[40];
#pragma unroll
        for (int b = 0; b < 40; ++b) acc[b] = 0.f;
        for (int kc = 0; kc < 4; ++kc) {
            __syncthreads();
            for (int i = tid; i < 40 * 256; i += NTHR) { const int b = i >> 8, kk = i & 255;
                const float cv = b < 8 ? a.cp[b * 1024 + kc * 256 + kk] : a.cs[(b - 8) * 1024 + kc * 256 + kk];
                sS[i] = cv * sigmoidf_(cv); }
            __syncthreads();
#pragma unroll
            for (int k8 = 0; k8 < 8; ++k8) { const float w = a.w_ada[(size_t)(kc * 256 + kq * 8 + k8) * 3072 + n0 + col];
#pragma unroll
                for (int b = 0; b < 40; ++b) acc[b] += sS[b * 256 + kq * 8 + k8] * w; }
        }
#pragma unroll
        for (int b = 0; b < 40; ++b) red[kq * 640 + col * 40 + b] = acc[b];
        __syncthreads();
        for (int o = tid; o < 640; o += NTHR) { float s = 0.f; for (int k = 0; k < 32; ++k) s += red[k * 640 + o];
            const int c = o / 40, b = o % 40; ada[b * 3072 + n0 + c] = s + a.b_ada[n0 + c]; }
        __syncthreads();
    }
    {
        LAS float* tile = (LAS float*)lds;
        for (int tl = bx; tl < 1024 + 384; tl += G) {
            const float* src; bf16_t* dst; int K, N, kt, nt;
            if (tl < 1024) { src = a.w_in; dst = (bf16_t*)(a.ws + WS_BT1); K = 1024; N = 4096; kt = tl >> 6; nt = tl & 63; }
            else { const int t2 = tl - 1024; src = a.w_out; dst = (bf16_t*)(a.ws + WS_BT2); K = 1536; N = 1024; kt = t2 >> 4; nt = t2 & 15; }
            __syncthreads();
#pragma unroll
            for (int ps = 0; ps < 2; ++ps) { const int rr = (tid >> 4) + ps * 32, c4 = (tid & 15) * 4;
                const f32x4 v = *(const f32x4*)(src + (size_t)(kt * 64 + rr) * N + nt * 64 + c4);
                tile[rr * 65 + c4 + 0] = v[0]; tile[rr * 65 + c4 + 1] = v[1]; tile[rr * 65 + c4 + 2] = v[2]; tile[rr * 65 + c4 + 3] = v[3]; }
            __syncthreads();
            { const int n = tid >> 3, k8 = tid & 7; float f[8];
#pragma unroll
              for (int e = 0; e < 8; ++e) f[e] = tile[(k8 * 8 + e) * 65 + n];
              *(u32x4*)(dst + (size_t)(nt * 64 + n) * K + kt * 64 + k8 * 8) = pack8(f); }
        }
        __syncthreads();
    }
    {
        bf16_t* wg = (bf16_t*)(a.ws + WS_WG);
        for (int i = bx * NTHR + tid; i < 131072; i += G * NTHR) {
            const int e = i & 7, lane = (i >> 3) & 63, ks = (i >> 9) & 1, nb = (i >> 10) & 3, g = (i >> 12) & 1, h = i >> 13;
            const int m = lane & 15, q = lane >> 4;
            const int k = ks * 32 + q * 8 + e, n = (nb >> 1) * 32 + (m >> 2) * 8 + (nb & 1) * 4 + (m & 3);
            const float v = (g ? a.w_ig : a.w_rg)[(size_t)h * 4096 + k * 64 + n];
            wg[i] = (bf16_t)(pg8::cvt_pk_bf16(-1.44269504f * v, 0.f) & 0xffffu);
        }
    }
}

__device__ void p1_norm(const Args& a) {
    const int lane = threadIdx.x & 63, gw = blockIdx.x * NWV + (threadIdx.x >> 6), nw = gridDim.x * NWV;
    const float* ada = (const float*)(a.ws + WS_ADA); bf16_t* hn = (bf16_t*)(a.ws + WS_HN);
    for (int rowa = gw; rowa < MT; rowa += 2 * nw) {
        const int nr = (rowa + nw < MT) ? 2 : 1;
        f32x4 v[2][4]; float ss[2] = {0.f, 0.f};
#pragma unroll
        for (int k = 0; k < 2; ++k) { const int row = (k < nr) ? rowa + k * nw : rowa;
            const float* xr = row < MP ? a.xp + (size_t)row * 1024 : a.xs + (size_t)(row - MP) * 1024;
#pragma unroll
            for (int i = 0; i < 4; ++i) v[k][i] = *(const f32x4*)(xr + (i * 64 + lane) * 4); }
#pragma unroll
        for (int k = 0; k < 2; ++k) {
#pragma unroll
            for (int i = 0; i < 4; ++i) ss[k] += v[k][i][0] * v[k][i][0] + v[k][i][1] * v[k][i][1] + v[k][i][2] * v[k][i][2] + v[k][i][3] * v[k][i][3];
#pragma unroll
            for (int o = 1; o < 64; o <<= 1) ss[k] += __shfl_xor(ss[k], o); }
#pragma unroll
        for (int k = 0; k < 2; ++k) { if (k < nr) { const int row = rowa + k * nw;
            const int b = row < MP ? (row >> 13) : 8 + ((row - MP) >> 4);
            const float rinv = rsqrtf(ss[k] * (1.f / 1024.f) + 1e-6f);
#pragma unroll
            for (int i = 0; i < 4; ++i) { const int c = (i * 64 + lane) * 4;
                const f32x4 g = *(const f32x4*)(a.g_norm + c), sc = *(const f32x4*)(ada + b * 3072 + 1024 + c), sh = *(const f32x4*)(ada + b * 3072 + c);
                const f32x4 o = (v[k][i] * rinv) * g * (sc + 1.f) + sh;
                uint2 w; w.x = pg8::cvt_pk_bf16(o[0], o[1]); w.y = pg8::cvt_pk_bf16(o[2], o[3]);
                *(uint2*)(hn + (size_t)row * 1024 + c) = w; } } }
    }
}

__device__ void p3_mixer_a1(const Args& a, LAS unsigned char* lds, const int gw, const int nw) {
    const int lane = threadIdx.x & 63, wv = threadIdx.x >> 6;
    const int r = lane & 15, q = lane >> 4;
    LAS float* tbl = (LAS float*)(lds + wv * 2048);
    const bf16_t* proj = (const bf16_t*)(a.ws + WS_PROJ); unsigned* LB = (unsigned*)(a.ws + WS_LB);
    float* agg = (float*)(a.ws + WS_AGG);
    for (int u = gw; u < 2560; u += nw) {
        int head, seq, chunk, L, tstart; size_t rowbase; bool sample, lastchunk;
        if (u < 2048) { head = u & 15; chunk = (u >> 4) & 15; seq = u >> 8; sample = false; rowbase = (size_t)seq * 8192; tstart = chunk * 512; L = 32; lastchunk = (chunk == 15); }
        else { const int v = u - 2048; head = v & 15; seq = v >> 4; chunk = 0; sample = true; rowbase = (size_t)MP + seq * 16; tstart = 0; L = 1; lastchunk = true; }
        __builtin_amdgcn_wave_barrier();
        { const int c = head * 64 + lane;
          tbl[0 * 64 + lane] = a.w_conv_a[0 * 1024 + c]; tbl[1 * 64 + lane] = a.w_conv_a[1 * 1024 + c]; tbl[2 * 64 + lane] = a.w_conv_a[2 * 1024 + c]; tbl[3 * 64 + lane] = a.w_conv_a[3 * 1024 + c];
          tbl[4 * 64 + lane] = a.b_conv_a[c]; tbl[5 * 64 + lane] = -1.44269504f * a.b_rg[c]; tbl[6 * 64 + lane] = -1.44269504f * a.b_ig[c];
          tbl[7 * 64 + lane] = -8.f * 1.44269504f * log1pf(__expf(-a.lam[c])); }
        __builtin_amdgcn_wave_barrier();
        bf16x8 wg[2][4][2];
        { const bf16x8* wgp = (const bf16x8*)(a.ws + WS_WG);
#pragma unroll
          for (int g = 0; g < 2; ++g)
#pragma unroll
            for (int nb = 0; nb < 4; ++nb)
#pragma unroll
              for (int ks = 0; ks < 2; ++ks) wg[g][nb][ks] = wgp[((((head * 2 + g) * 4 + nb) * 2 + ks) * 64) + lane]; }
        float hrun[16], prun[16];
#pragma unroll
        for (int i = 0; i < 16; ++i) { hrun[i] = 0.f; prun[i] = 1.f; }
        const int cb0 = head * 64 + q * 8;
        const int t0 = tstart + r * L;
        const bf16_t* prow = proj + (rowbase + t0) * 4096 + cb0;
        u32x4 W[3][2], Xn[2], Xn2[2];
#pragma unroll
        for (int kk = 0; kk < 3; ++kk)
#pragma unroll
            for (int ks = 0; ks < 2; ++ks) {
                const int trel = t0 - 3 + kk;
                u32x4 v = (u32x4){0u, 0u, 0u, 0u};
                if (trel >= 0) v = *(const u32x4*)(prow + (ptrdiff_t)(kk - 3) * 4096 + ks * 32);
                else if (sample) { const float* cpn = a.cache_a + ((size_t)seq * 3 + (3 + trel)) * 1024 + cb0 + ks * 32; float f[8];
#pragma unroll
                    for (int e = 0; e < 8; ++e) f[e] = cpn[e];
                    v = pack8(f); }
                W[kk][ks] = v; }
#pragma unroll
        for (int ks = 0; ks < 2; ++ks) { Xn[ks] = *(const u32x4*)(prow + ks * 32); Xn2[ks] = *(const u32x4*)(prow + (size_t)(L > 1 ? 1 : 0) * 4096 + ks * 32); }
        for (int blk = 0; blk < L; ++blk) {
            const size_t row = rowbase + t0 + blk;
            u32x4 Xc[2];
#pragma unroll
            for (int ks = 0; ks < 2; ++ks) { Xc[ks] = Xn[ks]; Xn[ks] = Xn2[ks]; }
            { const int nb2 = (blk + 2 < L) ? blk + 2 : L - 1;
#pragma unroll
              for (int ks = 0; ks < 2; ++ks) Xn2[ks] = *(const u32x4*)(prow + (size_t)nb2 * 4096 + ks * 32); }
            float xc[16]; bf16x8 af[2];
#pragma unroll
            for (int ks = 0; ks < 2; ++ks) {
                const int cl0 = ks * 32 + q * 8;
                float acc8[8];
                { const f32x4 b0 = *(const LAS f32x4*)(tbl + 4 * 64 + cl0), b1 = *(const LAS f32x4*)(tbl + 4 * 64 + cl0 + 4);
                  acc8[0] = b0[0]; acc8[1] = b0[1]; acc8[2] = b0[2]; acc8[3] = b0[3]; acc8[4] = b1[0]; acc8[5] = b1[1]; acc8[6] = b1[2]; acc8[7] = b1[3]; }
#pragma unroll
                for (int kk = 0; kk < 4; ++kk) {
                    float X[8]; unpack8(kk < 3 ? W[kk][ks] : Xc[ks], X);
                    const f32x4 w0 = *(const LAS f32x4*)(tbl + kk * 64 + cl0), w1 = *(const LAS f32x4*)(tbl + kk * 64 + cl0 + 4);
                    acc8[0] += w0[0] * X[0]; acc8[1] += w0[1] * X[1]; acc8[2] += w0[2] * X[2]; acc8[3] += w0[3] * X[3];
                    acc8[4] += w1[0] * X[4]; acc8[5] += w1[1] * X[5]; acc8[6] += w1[2] * X[6]; acc8[7] += w1[3] * X[7];
                }
#pragma unroll
                for (int e = 0; e < 8; ++e) xc[ks * 8 + e] = acc8[e];
                const u32x4 pk = pack8(acc8);
                af[ks] = __builtin_bit_cast(bf16x8, pk);
            }
            if (lastchunk && blk == L - 1 && r == 15) {
#pragma unroll
                for (int kk = 1; kk < 4; ++kk)
#pragma unroll
                    for (int ks = 0; ks < 2; ++ks) { float X[8]; unpack8(kk < 3 ? W[kk][ks] : Xc[ks], X);
                        float* o = a.out + (sample ? O_CAS : O_CAP) + ((size_t)seq * 3 + (kk - 1)) * 1024 + cb0 + ks * 32;
                        *(f32x4*)o = (f32x4){X[0], X[1], X[2], X[3]}; *(f32x4*)(o + 4) = (f32x4){X[4], X[5], X[6], X[7]}; }
            }
#pragma unroll
            for (int nb = 0; nb < 4; ++nb) {
                const int ks = nb >> 1, e0 = (nb & 1) * 4, cl0 = ks * 32 + q * 8 + e0, i0 = ks * 8 + e0;
                const f32x4 brg = *(const LAS f32x4*)(tbl + 5 * 64 + cl0), big = *(const LAS f32x4*)(tbl + 6 * 64 + cl0), nsp = *(const LAS f32x4*)(tbl + 7 * 64 + cl0);
                f32x4 R = __builtin_amdgcn_mfma_f32_16x16x32_bf16(wg[0][nb][0], af[0], brg, 0, 0, 0);
                R = __builtin_amdgcn_mfma_f32_16x16x32_bf16(wg[0][nb][1], af[1], R, 0, 0, 0);
                f32x4 I = __builtin_amdgcn_mfma_f32_16x16x32_bf16(wg[1][nb][0], af[0], big, 0, 0, 0);
                I = __builtin_amdgcn_mfma_f32_16x16x32_bf16(wg[1][nb][1], af[1], I, 0, 0, 0);
                u32x4 lbw;
#pragma unroll
                for (int j = 0; j < 4; ++j) {
                    const float rg = __builtin_amdgcn_rcpf(1.f + __builtin_amdgcn_exp2f(R[j]));
                    const float ig = __builtin_amdgcn_rcpf(1.f + __builtin_amdgcn_exp2f(I[j]));
                    const float la2 = nsp[j] * rg;
                    const float av = __builtin_amdgcn_exp2f(la2);
                    const float bb = __builtin_amdgcn_sqrtf(__builtin_fmaf(-av, av, 1.f)) * (ig * xc[i0 + j]);
                    lbw[j] = pg8::cvt_pk_bf16(la2, bb);
                    hrun[i0 + j] = __builtin_fmaf(av, hrun[i0 + j], bb);
                    prun[i0 + j] *= av;
                }
                *(u32x4*)(LB + row * 1024 + head * 64 + cl0) = lbw;
            }
#pragma unroll
            for (int ks = 0; ks < 2; ++ks) { W[0][ks] = W[1][ks]; W[1][ks] = W[2][ks]; W[2][ks] = Xc[ks]; }
        }
        if (!sample) {
#pragma unroll
            for (int g4 = 0; g4 < 4; ++g4) { const int i0 = g4 * 4;
                scan4(prun[i0], prun[i0 + 1], prun[i0 + 2], prun[i0 + 3], hrun[i0], hrun[i0 + 1], hrun[i0 + 2], hrun[i0 + 3], 0.f, 0.f, 0.f, 0.f); }
            if (r == 15) {
#pragma unroll
                for (int i = 0; i < 16; ++i) *(float2*)(agg + ((size_t)(seq * 16 + chunk) * 1024 + head * 64 + (i >> 3) * 32 + q * 8 + (i & 7)) * 2) = make_float2(prun[i], hrun[i]);
            }
        }
    }
}

struct A2Regs { u32x4 lb[4]; u32x4 g[2]; };
__device__ __forceinline__ void a2_load(A2Regs& R, const unsigned* LB, const bf16_t* proj, size_t row, int cb) {
#pragma unroll
    for (int ks = 0; ks < 2; ++ks) { const unsigned* lp = LB + row * 1024 + cb + ks * 32; R.lb[ks * 2] = *(const u32x4*)lp; R.lb[ks * 2 + 1] = *(const u32x4*)(lp + 4);
        R.g[ks] = *(const u32x4*)(proj + row * 4096 + 1024 + cb + ks * 32); }
}
__device__ __forceinline__ void a2_block(const A2Regs& R, float (&hprev)[16], bf16_t* ymix, size_t row, int cb, int r) {
#pragma unroll
    for (int ks = 0; ks < 2; ++ks) {
        float G[8]; unpack8(R.g[ks], G);
        float y[8];
#pragma unroll
        for (int hh = 0; hh < 2; ++hh) {
            const u32x4 w = R.lb[ks * 2 + hh]; const int i0 = ks * 8 + hh * 4;
            float av[4], bb[4], hm[4];
#pragma unroll
            for (int j = 0; j < 4; ++j) { av[j] = __builtin_amdgcn_exp2f(bf_lo(w[j])); bb[j] = bf_hi(w[j]); hm[j] = (r == 15) ? hprev[i0 + j] : 0.f; }
            scan4(av[0], av[1], av[2], av[3], bb[0], bb[1], bb[2], bb[3], hm[0], hm[1], hm[2], hm[3]);
#pragma unroll
            for (int j = 0; j < 4; ++j) { hprev[i0 + j] = bb[j]; const float g = G[hh * 4 + j]; y[hh * 4 + j] = bb[j] * (g * sigmoidf_(g)); }
        }
        *(u32x4*)(ymix + row * 1536 + cb + ks * 32) = pack8(y);
    }
}
__device__ void p4_mixer_a2(const Args& a) {
    const int lane = threadIdx.x & 63, wv = threadIdx.x >> 6, gw = blockIdx.x * NWV + wv, nw = gridDim.x * NWV;
    const int r = lane & 15, q = lane >> 4;
    const bf16_t* proj = (const bf16_t*)(a.ws + WS_PROJ); bf16_t* ymix = (bf16_t*)(a.ws + WS_YMIX); const unsigned* LB = (const unsigned*)(a.ws + WS_LB);
    const float* agg = (const float*)(a.ws + WS_AGG);
    for (int u = gw; u < 2560; u += nw) {
        int head, seq, chunk, nblk, tstart; size_t rowbase; bool sample, lastchunk;
        if (u < 2048) { head = u & 15; chunk = (u >> 4) & 15; seq = u >> 8; sample = false; rowbase = (size_t)seq * 8192; tstart = chunk * 512; nblk = 32; lastchunk = (chunk == 15); }
        else { const int v = u - 2048; head = v & 15; seq = v >> 4; chunk = 0; sample = true; rowbase = (size_t)MP + seq * 16; tstart = 0; nblk = 1; lastchunk = true; }
        const int cb = head * 64 + q * 8;
        float hprev[16];
#pragma unroll
        for (int i = 0; i < 16; ++i) hprev[i] = 0.f;
        if (sample) {
#pragma unroll
            for (int i = 0; i < 16; ++i) hprev[i] = a.state[(size_t)seq * 1024 + cb + (i >> 3) * 32 + (i & 7)];
        } else {
            for (int jj = 0; jj < chunk; ++jj) {
#pragma unroll
                for (int i = 0; i < 16; ++i) { const float2 ph = *(const float2*)(agg + ((size_t)(seq * 16 + jj) * 1024 + cb + (i >> 3) * 32 + (i & 7)) * 2);
                    hprev[i] = ph.x * hprev[i] + ph.y; }
            }
        }
        const size_t row0 = rowbase + tstart + r;
        if (nblk == 1) { A2Regs c0; a2_load(c0, LB, proj, row0, cb); a2_block(c0, hprev, ymix, row0, cb, r); }
        else {
            A2Regs c0, c1, n0, n1;
            a2_load(c0, LB, proj, row0, cb); a2_load(c1, LB, proj, row0 + 16, cb);
            for (int blk = 0; blk < nblk; blk += 2) {
                const size_t row = row0 + (size_t)blk * 16;
                const size_t rown = (blk + 2 < nblk) ? row + 32 : row;
                a2_load(n0, LB, proj, rown, cb); a2_load(n1, LB, proj, rown + 16, cb);
                a2_block(c0, hprev, ymix, row, cb, r); a2_block(c1, hprev, ymix, row + 16, cb, r);
                c0 = n0; c1 = n1;
            }
        }
        if (lastchunk && r == 15) {
#pragma unroll
            for (int ks = 0; ks < 2; ++ks) { float* o = a.out + (sample ? O_LRS : O_LRP) + (size_t)seq * 1024 + cb + ks * 32;
                *(f32x4*)o = (f32x4){hprev[ks * 8 + 0], hprev[ks * 8 + 1], hprev[ks * 8 + 2], hprev[ks * 8 + 3]};
                *(f32x4*)(o + 4) = (f32x4){hprev[ks * 8 + 4], hprev[ks * 8 + 5], hprev[ks * 8 + 6], hprev[ks * 8 + 7]}; }
        }
    }
}

__device__ void p3_mixer_b(const Args& a, const int tix, const int tn) {
    const bf16_t* proj = (const bf16_t*)(a.ws + WS_PROJ); bf16_t* ymix = (bf16_t*)(a.ws + WS_YMIX);
    for (int it = tix; it < (MP / 16) * 64; it += tn) {
        const int rb = it >> 6, cg = it & 63, c0 = cg * 8;
        const int seq = rb >> 9, t0 = (rb & 511) * 16;
        const size_t rowbase = (size_t)seq * 8192;
        float w[3][8];
#pragma unroll
        for (int k = 0; k < 3; ++k) { const f32x4 w0 = *(const f32x4*)(a.w_conv_b + k * 512 + c0), w1 = *(const f32x4*)(a.w_conv_b + k * 512 + c0 + 4);
            w[k][0] = w0[0]; w[k][1] = w0[1]; w[k][2] = w0[2]; w[k][3] = w0[3]; w[k][4] = w1[0]; w[k][5] = w1[1]; w[k][6] = w1[2]; w[k][7] = w1[3]; }
        float vm2[8], vm1[8];
        if (t0 > 0) {
            float xa[8], ca[8];
            unpack8(*(const u32x4*)(proj + (rowbase + t0 - 2) * 4096 + 2048 + c0), xa); unpack8(*(const u32x4*)(proj + (rowbase + t0 - 2) * 4096 + 3072 + c0), ca);
#pragma unroll
            for (int e = 0; e < 8; ++e) vm2[e] = xa[e] * ca[e];
            unpack8(*(const u32x4*)(proj + (rowbase + t0 - 1) * 4096 + 2048 + c0), xa); unpack8(*(const u32x4*)(proj + (rowbase + t0 - 1) * 4096 + 3072 + c0), ca);
#pragma unroll
            for (int e = 0; e < 8; ++e) vm1[e] = xa[e] * ca[e];
        } else {
#pragma unroll
            for (int e = 0; e < 8; ++e) { vm2[e] = 0.f; vm1[e] = 0.f; }
        }
        for (int tt = 0; tt < 16; ++tt) {
            const size_t row = rowbase + t0 + tt;
            float xb[8], cgt[8], bg[8], gb[8];
            unpack8(*(const u32x4*)(proj + row * 4096 + 2048 + c0), xb); unpack8(*(const u32x4*)(proj + row * 4096 + 2560 + c0), bg);
            unpack8(*(const u32x4*)(proj + row * 4096 + 3072 + c0), cgt); unpack8(*(const u32x4*)(proj + row * 4096 + 3584 + c0), gb);
            float y[8];
#pragma unroll
            for (int e = 0; e < 8; ++e) { const float v = cgt[e] * xb[e]; const float uu = w[0][e] * vm2[e] + w[1][e] * vm1[e] + w[2][e] * v;
                y[e] = bg[e] * uu * (gb[e] * sigmoidf_(gb[e])); vm2[e] = vm1[e]; vm1[e] = v; }
            *(u32x4*)(ymix + row * 1536 + 1024 + c0) = pack8(y);
        }
        if ((rb & 511) == 511) { float* o = a.out + O_CBP + (size_t)seq * 2 * 512 + c0;
#pragma unroll
            for (int e = 0; e < 8; ++e) { o[e] = vm2[e]; o[512 + e] = vm1[e]; } }
    }
    for (int it = tix; it < MS * 64; it += tn) {
        const int cg = it & 63, c0 = cg * 8, t = (it >> 6) & 15, seq = it >> 10;
        const size_t row = (size_t)MP + seq * 16 + t;
        float v[3][8];
#pragma unroll
        for (int k = 0; k < 3; ++k) { const int tr = t - 2 + k;
            if (tr >= 0) { float xa[8], ca[8]; unpack8(*(const u32x4*)(proj + (row - 2 + k) * 4096 + 2048 + c0), xa); unpack8(*(const u32x4*)(proj + (row - 2 + k) * 4096 + 3072 + c0), ca);
#pragma unroll
                for (int e = 0; e < 8; ++e) v[k][e] = xa[e] * ca[e]; }
            else {
#pragma unroll
                for (int e = 0; e < 8; ++e) v[k][e] = a.cache_b[((size_t)seq * 2 + (2 + tr)) * 512 + c0 + e]; } }
        float bg[8], gb[8], y[8];
        unpack8(*(const u32x4*)(proj + row * 4096 + 2560 + c0), bg); unpack8(*(const u32x4*)(proj + row * 4096 + 3584 + c0), gb);
#pragma unroll
        for (int e = 0; e < 8; ++e) { const float uu = a.w_conv_b[c0 + e] * v[0][e] + a.w_conv_b[512 + c0 + e] * v[1][e] + a.w_conv_b[1024 + c0 + e] * v[2][e];
            y[e] = bg[e] * uu * (gb[e] * sigmoidf_(gb[e])); }
        *(u32x4*)(ymix + row * 1536 + 1024 + c0) = pack8(y);
        if (t == 15) { float* o = a.out + O_CBS + (size_t)seq * 2 * 512 + c0;
#pragma unroll
            for (int e = 0; e < 8; ++e) { o[e] = v[1][e]; o[512 + e] = v[2][e]; } }
    }
}

__device__ void p5_final(const Args& a) {
    const int lane = threadIdx.x & 63, gw = blockIdx.x * NWV + (threadIdx.x >> 6), nw = gridDim.x * NWV;
    const float* rss = (const float*)(a.ws + WS_RSS);
    for (int row = gw; row < MT; row += nw) {
        float* yr = a.out + (size_t)row * 1024;
        float ss = lane < 16 ? rss[(size_t)row * 16 + lane] : 0.f;
#pragma unroll
        for (int o = 1; o < 16; o <<= 1) ss += __shfl_xor(ss, o);
        ss = __shfl(ss, 0);
        const float rinv = rsqrtf(ss * (1.f / 1024.f) + 1e-6f);
#pragma unroll
        for (int i = 0; i < 4; ++i) { const int c = (i * 64 + lane) * 4;
            const f32x4 v = *(const f32x4*)(yr + c), g = *(const f32x4*)(a.g_final + c);
            *(f32x4*)(yr + c) = (v * rinv) * g; }
    }
}


__device__ void p6_final(const Args& a) {
    const int lane = threadIdx.x & 63, gw = blockIdx.x * NWV + (threadIdx.x >> 6), nw = gridDim.x * NWV;
    const float* ada = (const float*)(a.ws + WS_ADA); const bf16_t* om = (const bf16_t*)(a.ws + WS_OM);
    for (int rowa = gw; rowa < MT; rowa += 2 * nw) {
        const int nr = (rowa + nw < MT) ? 2 : 1;
        f32x4 v[2][4]; uint2 w[2][4];
#pragma unroll
        for (int k = 0; k < 2; ++k) { const int row = (k < nr) ? rowa + k * nw : rowa;
            const float* xr = row < MP ? a.xp + (size_t)row * 1024 : a.xs + (size_t)(row - MP) * 1024;
#pragma unroll
            for (int i = 0; i < 4; ++i) { v[k][i] = *(const f32x4*)(xr + (i * 64 + lane) * 4); w[k][i] = *(const uint2*)(om + (size_t)row * 1024 + (i * 64 + lane) * 4); } }
        float ss[2] = {0.f, 0.f};
#pragma unroll
        for (int k = 0; k < 2; ++k) { const int row = (k < nr) ? rowa + k * nw : rowa;
            const int b = row < MP ? (row >> 13) : 8 + ((row - MP) >> 4);
#pragma unroll
            for (int i = 0; i < 4; ++i) { const f32x4 g = *(const f32x4*)(ada + (size_t)b * 3072 + 2048 + (i * 64 + lane) * 4);
                const f32x4 o = (f32x4){bf_lo(w[k][i].x), bf_hi(w[k][i].x), bf_lo(w[k][i].y), bf_hi(w[k][i].y)};
                v[k][i] = v[k][i] + g * o;
                ss[k] += v[k][i][0] * v[k][i][0] + v[k][i][1] * v[k][i][1] + v[k][i][2] * v[k][i][2] + v[k][i][3] * v[k][i][3]; }
#pragma unroll
            for (int o = 1; o < 64; o <<= 1) ss[k] += __shfl_xor(ss[k], o); }
#pragma unroll
        for (int k = 0; k < 2; ++k) { if (k < nr) { const int row = rowa + k * nw;
            const float rinv = rsqrtf(ss[k] * (1.f / 1024.f) + 1e-6f);
            float* yr = a.out + (size_t)row * 1024;
#pragma unroll
            for (int i = 0; i < 4; ++i) { const int c = (i * 64 + lane) * 4; const f32x4 g = *(const f32x4*)(a.g_final + c);
                *(f32x4*)(yr + c) = (v[k][i] * rinv) * g; } } }
    }
}

__global__ void __launch_bounds__(NTHR, 2) mega_fwd(Args a) {
    extern __shared__ __attribute__((aligned(16))) unsigned char lds_raw[];
    LAS unsigned char* lds = (LAS unsigned char*)lds_raw;
    cg::grid_group grid = cg::this_grid();
    const int lo = a.ph_lo, hi = a.ph_hi;
    if (hi > 1000) grid.sync();
    if (threadIdx.x < 4) ((LAS unsigned*)(lds + pg8::STAGE_BYTES))[threadIdx.x] = 0u;
    __syncthreads();
    XcdBarrier bar = xcd_barrier_post((unsigned*)(a.ws + WS_BAR), (volatile LAS unsigned*)(lds + pg8::STAGE_BYTES));
#define IN(k) (lo <= (k) && (k) < hi)
#define SEAM(k) do { if (IN(k) && IN((k) + 1)) xcd_barrier(bar); } while (0)
    if (IN(0)) p0_prologue(a, lds);
    SEAM(0);
    if (IN(1)) p1_norm(a);
    SEAM(1);
    if (IN(2)) { pg8::Gemm g{(const bf16_t*)(a.ws + WS_HN), (const bf16_t*)(a.ws + WS_BT1), MT, 4096, 1024}; pg8::StaticOrder S; S.init(MT, 4096, (int)gridDim.x, (int)blockIdx.x);
        pg8::EpiBf16 E{(bf16_t*)(a.ws + WS_PROJ), 4096};
        pg8::gemm_phase_sp2<pg8::EpiBf16, pg8::StaticOrder, true, true>(lds, g, S, E); }
    SEAM(2);
    if (IN(3)) {
        if (threadIdx.x < 256) p3_mixer_a1(a, lds, (int)blockIdx.x * 4 + (int)(threadIdx.x >> 6), (int)gridDim.x * 4);
        else p3_mixer_b(a, (int)blockIdx.x * 256 + (int)threadIdx.x - 256, (int)gridDim.x * 256); }
    SEAM(3);
    if (IN(4)) p4_mixer_a2(a);
    SEAM(4);
    if (IN(5)) { pg8::Gemm g{(const bf16_t*)(a.ws + WS_YMIX), (const bf16_t*)(a.ws + WS_BT2), MT, 1024, 1536}; pg8::StaticOrder S; S.init(MT, 1024, (int)gridDim.x, (int)blockIdx.x);
        pg8::EpiBf16 E{(bf16_t*)(a.ws + WS_OM), 1024};
        pg8::gemm_phase_sp2<pg8::EpiBf16, pg8::StaticOrder, true, true>(lds, g, S, E); }
    SEAM(5);
    if (IN(6)) p6_final(a);
#undef IN
#undef SEAM
}

#ifndef N_LAUNCHES
#define N_LAUNCHES 1
#endif
constexpr int NPH = 7, LDS_BYTES = pg8::STAGE_BYTES + 16;

extern "C" void kernel_launch(void* const* d_in, const int* in_sizes, int n_in, void* d_out, int out_size, void* d_ws, size_t ws_size, hipStream_t stream) {
    static int grid = 0;
    if (grid == 0) {
        if (n_in != 21 || (size_t)out_size != O_END || ws_size < WS_END) { fprintf(stderr, "kernel_launch: unexpected shapes (n_in %d out %d ws %zu need %zu)\n", n_in, out_size, ws_size, (size_t)WS_END); grid = -1; return; }
        int dev = 0, cus = 0, per_cu = 0;
        hipGetDevice(&dev); hipDeviceGetAttribute(&cus, hipDeviceAttributeMultiprocessorCount, dev);
        if (hipFuncSetAttribute((const void*)mega_fwd, hipFuncAttributeMaxDynamicSharedMemorySize, LDS_BYTES) != hipSuccess) { fprintf(stderr, "kernel_launch: hipFuncSetAttribute failed\n"); grid = -1; return; }
        if (hipOccupancyMaxActiveBlocksPerMultiprocessor(&per_cu, (const void*)mega_fwd, NTHR, LDS_BYTES) != hipSuccess || per_cu < 1) { fprintf(stderr, "kernel_launch: occupancy query says %d\n", per_cu); per_cu = 1; }
        (void)hipGetLastError();
        grid = cus * 1;
    }
    if (grid < 0) return;
    if (hipMemsetAsync((char*)d_ws + WS_BAR, 0, XCD_BAR_WORDS * 4, stream) != hipSuccess) { fprintf(stderr, "kernel_launch: memset failed\n"); return; }
    Args a{};
    const float** ip = (const float**)&a;
    for (int i = 0; i < 21; ++i) ip[i] = (const float*)d_in[i];
    a.out = (float*)d_out; a.ws = (unsigned char*)d_ws;
#if N_LAUNCHES == 1
    a.ph_lo = 0; a.ph_hi = NPH;
    void* args[] = {&a};
    hipError_t e = hipLaunchCooperativeKernel((const void*)mega_fwd, dim3(grid), dim3(NTHR), args, LDS_BYTES, stream);
    if (e != hipSuccess) fprintf(stderr, "cooperative launch failed: %s (grid %d)\n", hipGetErrorString(e), grid);
#else
    for (int ph = 0; ph < NPH; ++ph) { a.ph_lo = ph; a.ph_hi = ph + 1; hipLaunchKernelGGL(mega_fwd, dim3(grid), dim3(NTHR), LDS_BYTES, stream, a); }
#endif
}
```

```cpp
#include <hip/hip_cooperative_groups.h>
#include <cstdio>
#include <cstdint>
namespace cg = cooperative_groups;
#include <hip/hip_runtime.h>
namespace pg8 {
#define PG8_LAS __attribute__((address_space(3)))
typedef unsigned short bf16_t;
typedef short bf16x8 __attribute__((ext_vector_type(8)));
typedef float f32x4 __attribute__((ext_vector_type(4)));
typedef unsigned u32x4 __attribute__((ext_vector_type(4)));
constexpr int BM = 256, BK = 64, HALF = 128, HTB = HALF * BK * 2  , STAGE_BYTES = 8 * HTB, NXCD = 8, WGM = 8;

__host__ __device__ __forceinline__ int lds_byte(int r, int c) { const int st = (r >> 4) * 2 + (c >> 5), rr = r & 15, cc = c & 31, ob = rr * 64 + cc * 2; return st * 1024 + (ob ^ (((ob >> 9) & 1) << 5)); }
__host__ __device__ __forceinline__ void stage_rc(int b, int& R, int& C) { const int st = b / 1024, sb = b % 1024, swz = sb ^ (((sb >> 9) & 1) << 5); R = (st >> 1) * 16 + swz / 64; C = (st & 1) * 32 + (swz % 64) / 2; }
__host__ __device__ __forceinline__ int perm32(int rho) { const int n = rho >> 4, i = rho & 15; return 8 * (i >> 2) + 4 * n + (i & 3); }

struct Unit { int pm, pn; };
struct Gemm { const bf16_t* A; const bf16_t* Bt; int M, N, K; };

struct StaticOrder {
    int nM, nN, nwg, G, c;
    __host__ __device__ void init(int M, int N, int G_, int c_) { nM = M / BM; nN = N / BM; nwg = nM * nN; G = G_; c = c_; }
    __host__ __device__ bool next(int i, Unit& u) const {
        const long L = (long)i * G + c; if (L >= nwg) return false;
        int wgid = (int)L; { const int q = nwg / NXCD, r = nwg % NXCD, xcd = wgid % NXCD, off = wgid / NXCD; wgid = (xcd < r ? xcd * (q + 1) : r * (q + 1) + (xcd - r) * q) + off; }
        const int nig = WGM * nN, gid = wgid / nig, fm = gid * WGM, gsz = (nM - fm) < WGM ? (nM - fm) : WGM;
        u.pm = fm + ((wgid % nig) % gsz); u.pn = (wgid % nig) / gsz; return true;
    }
    __device__ __forceinline__ void a_ready(const Unit&) const {}
    __device__ __forceinline__ void done(const Unit&) const {}
};
__device__ __forceinline__ unsigned cvt_pk_bf16(float lo, float hi) { unsigned r; asm volatile("v_cvt_pk_bf16_f32 %0, %1, %2" : "=v"(r) : "v"(lo), "v"(hi)); return r; }
struct EpiBf16 {
    static constexpr bool PERM = true, AFTER_DRAIN = false;
    bf16_t* O; int ldc;
    __device__ __forceinline__ void operator()(const f32x4 (&acc)[2][2][4][2], const Unit& u, int wr, int wc, int fr, int fq) const {
        const int row0 = u.pm * BM + wr * 64 + fr; const int col0 = u.pn * BM + wc * 32 + 8 * fq;
#pragma unroll
        for (int ai = 0; ai < 2; ++ai)
#pragma unroll
            for (int m = 0; m < 4; ++m) { bf16_t* rowp = O + (size_t)(row0 + ai * HALF + m * 16) * ldc + col0;
#pragma unroll
                for (int bj = 0; bj < 2; ++bj) { const f32x4 v0 = acc[ai][bj][m][0], v1 = acc[ai][bj][m][1];
                    u32x4 w; w.x = cvt_pk_bf16(v0[0], v0[1]); w.y = cvt_pk_bf16(v0[2], v0[3]); w.z = cvt_pk_bf16(v1[0], v1[1]); w.w = cvt_pk_bf16(v1[2], v1[3]);
                    *(u32x4*)(rowp + bj * HALF) = w; } }
    }
};
struct EpiRes {
    static constexpr bool PERM = false, AFTER_DRAIN = false;
    const float* xp; const float* xs; const float* ada; float* out; float* rss;
    __device__ __forceinline__ void operator()(const f32x4 (&acc)[2][2][4][2], const Unit& u, int wr, int wc, int fr, int fq) const {
        const int col0 = u.pn * BM + wc * 32 + 4 * fq;
#pragma unroll
        for (int ai = 0; ai < 2; ++ai)
#pragma unroll
            for (int m = 0; m < 4; ++m) {
                const int row = u.pm * BM + ai * HALF + wr * 64 + m * 16 + fr;
                const float* xr = row < 65536 ? xp + (size_t)row * 1024 : xs + (size_t)(row - 65536) * 1024;
                const int b = row < 65536 ? (row >> 13) : 8 + ((row - 65536) >> 4);
                const float* gr = ada + (size_t)b * 3072 + 2048;
                float* orow = out + (size_t)row * 1024;
                float s = 0.f;
#pragma unroll
                for (int bj = 0; bj < 2; ++bj)
#pragma unroll
                    for (int n = 0; n < 2; ++n) { const int c = col0 + bj * HALF + n * 16;
                        const f32x4 xv = *(const f32x4*)(xr + c), gv = *(const f32x4*)(gr + c);
                        const f32x4 o = xv + gv * acc[ai][bj][m][n];
                        *(f32x4*)(orow + c) = o; s += o[0] * o[0] + o[1] * o[1] + o[2] * o[2] + o[3] * o[3]; }
                s += __shfl_xor(s, 16); s += __shfl_xor(s, 32);
                if (fq == 0) rss[(size_t)row * 16 + u.pn * 4 + wc] = s;
            }
    }
};

struct EpiResNorm {
    static constexpr bool PERM = false, AFTER_DRAIN = false;
    const float* xp; const float* xs; const float* ada; const float* gfin; float* out; float* xbuf; unsigned* cnt;
    __device__ __forceinline__ void operator()(f32x4 (&acc)[2][2][4][2], const Unit& u, int wr, int wc, int fr, int fq) const {
        const int col0 = u.pn * BM + wc * 32 + 4 * fq;
#pragma unroll
        for (int ai = 0; ai < 2; ++ai)
#pragma unroll
            for (int m = 0; m < 4; ++m) {
                const int row = u.pm * BM + ai * HALF + wr * 64 + m * 16 + fr;
                const float* xr = row < 65536 ? xp + (size_t)row * 1024 : xs + (size_t)(row - 65536) * 1024;
                const int b = row < 65536 ? (row >> 13) : 8 + ((row - 65536) >> 4);
                const float* gr = ada + (size_t)b * 3072 + 2048;
                float s = 0.f;
#pragma unroll
                for (int bj = 0; bj < 2; ++bj)
#pragma unroll
                    for (int n = 0; n < 2; ++n) { const int c = col0 + bj * HALF + n * 16;
                        const f32x4 xv = *(const f32x4*)(xr + c), gv = *(const f32x4*)(gr + c);
                        const f32x4 o = xv + gv * acc[ai][bj][m][n];
                        acc[ai][bj][m][n] = o; s += o[0] * o[0] + o[1] * o[1] + o[2] * o[2] + o[3] * o[3]; }
                s += __shfl_xor(s, 16); s += __shfl_xor(s, 32);
                if (fq == 0) __hip_atomic_store(xbuf + (size_t)row * 16 + u.pn * 4 + wc, s, __ATOMIC_RELAXED, __HIP_MEMORY_SCOPE_AGENT);
            }
        asm volatile("s_waitcnt vmcnt(0)" ::: "memory");
        unsigned* c = cnt + (size_t)(u.pm * 2 + wr) * 64;
        if (fr == 0 && fq == 0) __hip_atomic_fetch_add(c, 1u, __ATOMIC_RELAXED, __HIP_MEMORY_SCOPE_AGENT);
        { const unsigned long long t0 = __builtin_amdgcn_s_memrealtime();
          while ((unsigned)__builtin_amdgcn_readfirstlane(__hip_atomic_load(c, __ATOMIC_RELAXED, __HIP_MEMORY_SCOPE_AGENT)) < 16u) {
              if (__builtin_amdgcn_s_memrealtime() - t0 > 4000000ull) break;
              __builtin_amdgcn_s_sleep(2); } }
        asm volatile("" ::: "memory");
#pragma unroll
        for (int ai = 0; ai < 2; ++ai)
#pragma unroll
            for (int m = 0; m < 4; ++m) {
                const int row = u.pm * BM + ai * HALF + wr * 64 + m * 16 + fr;
                const float* xb = xbuf + (size_t)row * 16 + fq * 4;
                float t = (__hip_atomic_load(xb, __ATOMIC_RELAXED, __HIP_MEMORY_SCOPE_AGENT) + __hip_atomic_load(xb + 1, __ATOMIC_RELAXED, __HIP_MEMORY_SCOPE_AGENT))
                        + (__hip_atomic_load(xb + 2, __ATOMIC_RELAXED, __HIP_MEMORY_SCOPE_AGENT) + __hip_atomic_load(xb + 3, __ATOMIC_RELAXED, __HIP_MEMORY_SCOPE_AGENT));
                t += __shfl_xor(t, 16); t += __shfl_xor(t, 32);
                const float rinv = rsqrtf(t * (1.f / 1024.f) + 1e-6f);
                float* orow = out + (size_t)row * 1024;
#pragma unroll
                for (int bj = 0; bj < 2; ++bj)
#pragma unroll
                    for (int n = 0; n < 2; ++n) { const int cc = col0 + bj * HALF + n * 16;
                        const f32x4 g = *(const f32x4*)(gfin + cc);
                        *(f32x4*)(orow + cc) = (acc[ai][bj][m][n] * rinv) * g; }
            }
    }
};
struct RowOrder {
    int G, c, nM;
    __host__ __device__ void init(int M, int G_, int c_) { nM = M / BM; G = G_; c = c_; }
    __host__ __device__ bool next(int i, Unit& u) const {
        int pslot, pn;
        if ((G & 31) == 0) { const int xcd = c & 7, slot = c >> 3; pslot = xcd * (G >> 5) + (slot >> 2); pn = slot & 3; }
        else { pslot = c >> 2; pn = c & 3; if (c >= (G & ~3)) return false; }
        const int pm = i * (G >> 2) + pslot; if (pm >= nM) return false;
        u.pm = pm; u.pn = pn; return true;
    }
    __device__ __forceinline__ void a_ready(const Unit&) const {}
    __device__ __forceinline__ void done(const Unit&) const {}
};

template <class Epi, class Sched, bool STAMP = false, bool ALIGN_EPI = true>
__device__ __forceinline__ void gemm_phase(PG8_LAS unsigned char* lds, const Gemm g, const Sched& S, const Epi& E, unsigned long long* stamps) {
    const int tid = threadIdx.x, wid = __builtin_amdgcn_readfirstlane(tid >> 6), lane = tid & 63, wr = wid >> 2, wc = wid & 3, fr = lane & 15, fq = lane >> 4;
    const int K = g.K, nt = K / BK;
    int ts_lo = 0, ts_hi = 0, nts = 0; const unsigned long long rt_entry = STAMP ? (unsigned long long)wall_clock64() : 0ull;
#define PG8_STAMP() do { if (STAMP && wid == 0 && nts < 64) { const unsigned long long _c = (unsigned long long)clock64(); \
        ts_lo = (lane == nts) ? (int)(unsigned)_c : ts_lo; ts_hi = (lane == nts) ? (int)(unsigned)(_c >> 32) : ts_hi; ++nts; } } while (0)
    PG8_STAMP();
    unsigned voffA[2], voffB[2];
#pragma unroll
    for (int i = 0; i < 2; ++i) { int R, C; stage_rc(tid * 16 + i * 8192, R, C); const int Rb = Epi::PERM ? ((R & ~31) + perm32(R & 31)) : R;
        voffA[i] = (unsigned)(R * K + C) * 2u; voffB[i] = (unsigned)(Rb * K + C) * 2u; }
    const size_t kstep = (size_t)(BK * 2);
    const size_t hstep = (size_t)HALF * K * 2;
    const size_t tstep = 2 * hstep;
    const unsigned ldsw = (unsigned)wid * 1024u;
    const int aoff = lds_byte(wr * 64 + fr, fq * 8), boff = lds_byte(wc * 32 + fr, fq * 8);
#define PG8_SA(b, h) (((b) * 2 + (h)) * HTB)
#define PG8_SB(b, h) ((4 + (b) * 2 + (h)) * HTB)
#define PG8_STAGE(bufoff, gbase, voff) do { _Pragma("unroll") for (int _i = 0; _i < 2; ++_i) \
        __builtin_amdgcn_global_load_lds((const unsigned*)((const char*)(gbase) + (voff)[_i]), (PG8_LAS unsigned*)(lds + (bufoff) + ldsw + _i * 8192), 16, 0, 0); } while (0)
#define PG8_LDA(dst, b, h) do { _Pragma("unroll") for (int m = 0; m < 4; ++m) _Pragma("unroll") for (int k = 0; k < 2; ++k) dst[m][k] = *(const PG8_LAS bf16x8*)(lds + PG8_SA(b, h) + aoff + m * 2048 + k * 1024); } while (0)
#define PG8_LDB(dst, b, h) do { _Pragma("unroll") for (int n = 0; n < 2; ++n) _Pragma("unroll") for (int k = 0; k < 2; ++k) dst[n][k] = *(const PG8_LAS bf16x8*)(lds + PG8_SB(b, h) + boff + n * 2048 + k * 1024); } while (0)
#define PG8_MMA(ai, bj, At, Bt) do { __builtin_amdgcn_s_setprio(1); _Pragma("unroll") for (int m = 0; m < 4; ++m) _Pragma("unroll") for (int n = 0; n < 2; ++n) _Pragma("unroll") for (int k = 0; k < 2; ++k) \
        acc[ai][bj][m][n] = __builtin_amdgcn_mfma_f32_16x16x32_bf16(Bt[n][k], At[m][k], acc[ai][bj][m][n], 0, 0, 0); __builtin_amdgcn_s_setprio(0); } while (0)
#define PG8_WAIT_V(n) asm volatile("s_waitcnt vmcnt(" #n ")" ::: "memory")
#define PG8_WAIT_L(n) asm volatile("s_waitcnt lgkmcnt(" #n ")" ::: "memory")
#define PG8_BAR __builtin_amdgcn_s_barrier()
#define PG8_SCHED __builtin_amdgcn_sched_barrier(0)
    Unit cur, nxt; int ui = 0;
    if (!S.next(0, cur)) return;
    f32x4 acc[2][2][4][2];
#pragma unroll
    for (int a = 0; a < 2; ++a)
#pragma unroll
        for (int b = 0; b < 2; ++b)
#pragma unroll
            for (int m = 0; m < 4; ++m)
#pragma unroll
                for (int n = 0; n < 2; ++n) acc[a][b][m][n] = (f32x4){0.f, 0.f, 0.f, 0.f};
    bf16x8 At[4][2], B0[2][2], B1[2][2];
    const char* cA = (const char*)g.A + (size_t)cur.pm * tstep; const char* cB = (const char*)g.Bt + (size_t)cur.pn * tstep;
    S.a_ready(cur);
    PG8_STAGE(PG8_SB(0, 0), cB, voffB); PG8_STAGE(PG8_SA(0, 0), cA, voffA); PG8_STAGE(PG8_SB(0, 1), cB + hstep, voffB); PG8_STAGE(PG8_SA(0, 1), cA + hstep, voffA);
    if (wr == 1) PG8_BAR;
    PG8_WAIT_V(4); PG8_BAR;
    PG8_STAGE(PG8_SB(1, 0), cB + kstep, voffB); PG8_STAGE(PG8_SA(1, 0), cA + kstep, voffA); PG8_STAGE(PG8_SB(1, 1), cB + hstep + kstep, voffB);
    PG8_WAIT_V(6); PG8_BAR;
    PG8_STAMP();
    for (;;) {
        const bool has_next = S.next(ui + 1, nxt);
        const char* nA = has_next ? (const char*)g.A + (size_t)nxt.pm * tstep : cA; const char* nB = has_next ? (const char*)g.Bt + (size_t)nxt.pn * tstep : cB;
        for (int t = 0; t < nt; t += 2) {
            const bool last = (t == nt - 2);
            const char* a1 = cA + (size_t)(t + 1) * kstep;
            const char* a2 = last ? nA : cA + (size_t)(t + 2) * kstep; const char* b2 = last ? nB : cB + (size_t)(t + 2) * kstep;
            const char* a3 = a2 + kstep; const char* b3 = b2 + kstep;
            if (last && has_next) S.a_ready(nxt);
            PG8_LDB(B0, 0, 0); PG8_SCHED; PG8_LDA(At, 0, 0); PG8_STAGE(PG8_SA(1, 1), a1 + hstep, voffA);
            PG8_WAIT_L(8); PG8_BAR; PG8_WAIT_L(0); PG8_MMA(0, 0, At, B0); PG8_BAR; PG8_SCHED;
            PG8_LDB(B1, 0, 1); PG8_STAGE(PG8_SB(0, 0), b2, voffB);
            PG8_BAR; PG8_WAIT_L(0); PG8_MMA(0, 1, At, B1); PG8_BAR;
            PG8_LDA(At, 0, 1); PG8_STAGE(PG8_SA(0, 0), a2, voffA);
            PG8_BAR; PG8_WAIT_L(0); PG8_MMA(1, 0, At, B0); PG8_BAR; PG8_SCHED;
            PG8_STAGE(PG8_SB(0, 1), b2 + hstep, voffB);
            PG8_WAIT_V(6); PG8_BAR; PG8_MMA(1, 1, At, B1); PG8_BAR;
            PG8_LDB(B0, 1, 0); PG8_SCHED; PG8_LDA(At, 1, 0); PG8_STAGE(PG8_SA(0, 1), a2 + hstep, voffA);
            PG8_WAIT_L(8); PG8_BAR; PG8_WAIT_L(0); PG8_MMA(0, 0, At, B0); PG8_BAR; PG8_SCHED;
            PG8_LDB(B1, 1, 1); PG8_STAGE(PG8_SB(1, 0), b3, voffB);
            PG8_BAR; PG8_WAIT_L(0); PG8_MMA(0, 1, At, B1); PG8_BAR;
            PG8_LDA(At, 1, 1); PG8_STAGE(PG8_SA(1, 0), a3, voffA);
            PG8_BAR; PG8_WAIT_L(0); PG8_MMA(1, 0, At, B0); PG8_BAR; PG8_SCHED;
            PG8_STAGE(PG8_SB(1, 1), b3 + hstep, voffB);
            PG8_WAIT_V(6); PG8_BAR; PG8_MMA(1, 1, At, B1); PG8_BAR;
        }
        PG8_STAMP();
        if constexpr (ALIGN_EPI) { if (wr == 0) PG8_BAR; }
        if constexpr (!Epi::AFTER_DRAIN) { E(acc, cur, wr, wc, fr, fq); S.done(cur); }
        PG8_STAMP();
        if (!has_next) break;
#pragma unroll
        for (int a = 0; a < 2; ++a)
#pragma unroll
            for (int b = 0; b < 2; ++b)
#pragma unroll
                for (int m = 0; m < 4; ++m)
#pragma unroll
                    for (int n = 0; n < 2; ++n) acc[a][b][m][n] = (f32x4){0.f, 0.f, 0.f, 0.f};
        cur = nxt; cA = nA; cB = nB; ++ui;
        if constexpr (ALIGN_EPI) { if (wr == 1) PG8_BAR; }
    }
    PG8_WAIT_V(0);
    if constexpr (!ALIGN_EPI) { if (wr == 0) PG8_BAR; }
    PG8_BAR;
    if constexpr (Epi::AFTER_DRAIN) { E.fused(acc, cur, wr, wc, fr, fq, lds, wid, lane); S.done(cur); }
    PG8_STAMP();
    if (STAMP && wid == 0) { stamps[lane] = lane < nts ? (((unsigned long long)(unsigned)ts_hi << 32) | (unsigned)ts_lo) : 0ull;
        if (lane == 62) stamps[62] = rt_entry; if (lane == 63) stamps[63] = (unsigned long long)wall_clock64(); }
#undef PG8_STAMP
#undef PG8_SA
#undef PG8_SB
#undef PG8_STAGE
#undef PG8_LDA
#undef PG8_LDB
#undef PG8_MMA
#undef PG8_WAIT_V
#undef PG8_WAIT_L
#undef PG8_BAR
#undef PG8_SCHED
}
template <class Epi, class Sched, bool ALIGN_EPI = false, bool SP2 = false>
__device__ __forceinline__ void gemm_phase_sp2(PG8_LAS unsigned char* lds, const Gemm g, const Sched& S, const Epi& E) {
    const int tid = threadIdx.x, wid = __builtin_amdgcn_readfirstlane(tid >> 6), lane = tid & 63, wr = wid >> 2, wc = wid & 3, fr = lane & 15, fq = lane >> 4;
    const int K = g.K, nt = K / BK;
    unsigned voffA[2], voffB[2];
#pragma unroll
    for (int i = 0; i < 2; ++i) { int R, C; stage_rc(tid * 16 + i * 8192, R, C); const int Rb = Epi::PERM ? ((R & ~31) + perm32(R & 31)) : R;
        voffA[i] = (unsigned)(R * K + C) * 2u; voffB[i] = (unsigned)(Rb * K + C) * 2u; }
    const size_t kstep = (size_t)(BK * 2);
    const size_t hstep = (size_t)HALF * K * 2;
    const size_t tstep = 2 * hstep;
    const unsigned ldsw = (unsigned)wid * 1024u;
    const int aoff = lds_byte(wr * 64 + fr, fq * 8), boff = lds_byte(wc * 32 + fr, fq * 8);
#define PG8_SA(b, h) (((b) * 2 + (h)) * HTB)
#define PG8_SB(b, h) ((4 + (b) * 2 + (h)) * HTB)
#define PG8_STAGE(bufoff, gbase, voff) do { _Pragma("unroll") for (int _i = 0; _i < 2; ++_i) \
        __builtin_amdgcn_global_load_lds((const unsigned*)((const char*)(gbase) + (voff)[_i]), (PG8_LAS unsigned*)(lds + (bufoff) + ldsw + _i * 8192), 16, 0, 0); } while (0)
#define PG8_LDA(dst, b, h) do { _Pragma("unroll") for (int m = 0; m < 4; ++m) _Pragma("unroll") for (int k = 0; k < 2; ++k) dst[m][k] = *(const PG8_LAS bf16x8*)(lds + PG8_SA(b, h) + aoff + m * 2048 + k * 1024); } while (0)
#define PG8_LDB(dst, b, h) do { _Pragma("unroll") for (int n = 0; n < 2; ++n) _Pragma("unroll") for (int k = 0; k < 2; ++k) dst[n][k] = *(const PG8_LAS bf16x8*)(lds + PG8_SB(b, h) + boff + n * 2048 + k * 1024); } while (0)
#define PG8_MMA(ai, bj, At, Bt) do { __builtin_amdgcn_s_setprio(1); _Pragma("unroll") for (int m = 0; m < 4; ++m) _Pragma("unroll") for (int n = 0; n < 2; ++n) _Pragma("unroll") for (int k = 0; k < 2; ++k) \
        acc[ai][bj][m][n] = __builtin_amdgcn_mfma_f32_16x16x32_bf16(Bt[n][k], At[m][k], acc[ai][bj][m][n], 0, 0, 0); __builtin_amdgcn_s_setprio(0); } while (0)
#define PG8_WAIT_V(n) asm volatile("s_waitcnt vmcnt(" #n ")" ::: "memory")
#define PG8_WAIT_L(n) asm volatile("s_waitcnt lgkmcnt(" #n ")" ::: "memory")
#define PG8_BAR __builtin_amdgcn_s_barrier()
#define PG8_SCHED __builtin_amdgcn_sched_barrier(0)
    Unit cur, nxt; int ui = 0;
    if (!S.next(0, cur)) return;
    f32x4 acc[2][2][4][2];
#pragma unroll
    for (int a = 0; a < 2; ++a)
#pragma unroll
        for (int b = 0; b < 2; ++b)
#pragma unroll
            for (int m = 0; m < 4; ++m)
#pragma unroll
                for (int n = 0; n < 2; ++n) acc[a][b][m][n] = (f32x4){0.f, 0.f, 0.f, 0.f};
    bf16x8 At[4][2], B0[2][2], B1[2][2];
    const char* cA = (const char*)g.A + (size_t)cur.pm * tstep; const char* cB = (const char*)g.Bt + (size_t)cur.pn * tstep;
    S.a_ready(cur);
    if constexpr (SP2) {
        PG8_STAGE(PG8_SB(0, 0), cB, voffB); PG8_STAGE(PG8_SB(0, 1), cB + hstep, voffB); PG8_STAGE(PG8_SA(0, 0), cA, voffA); PG8_STAGE(PG8_SA(0, 1), cA + hstep, voffA);
        if (wr == 1) PG8_BAR;
        PG8_WAIT_V(2); PG8_BAR;
        PG8_STAGE(PG8_SB(1, 0), cB + kstep, voffB); PG8_STAGE(PG8_SA(1, 0), cA + kstep, voffA); PG8_STAGE(PG8_SB(1, 1), cB + hstep + kstep, voffB);
        PG8_WAIT_V(6); PG8_BAR;
    } else {
        PG8_STAGE(PG8_SB(0, 0), cB, voffB); PG8_STAGE(PG8_SA(0, 0), cA, voffA); PG8_STAGE(PG8_SB(0, 1), cB + hstep, voffB); PG8_STAGE(PG8_SA(0, 1), cA + hstep, voffA);
        if (wr == 1) PG8_BAR;
        PG8_WAIT_V(4); PG8_BAR;
        PG8_STAGE(PG8_SB(1, 0), cB + kstep, voffB); PG8_STAGE(PG8_SA(1, 0), cA + kstep, voffA); PG8_STAGE(PG8_SB(1, 1), cB + hstep + kstep, voffB);
        PG8_WAIT_V(6); PG8_BAR;
    }
    for (;;) {
        const bool has_next = S.next(ui + 1, nxt);
        const char* nA = has_next ? (const char*)g.A + (size_t)nxt.pm * tstep : cA; const char* nB = has_next ? (const char*)g.Bt + (size_t)nxt.pn * tstep : cB;
        for (int t = 0; t < nt; t += 2) {
            const bool last = (t == nt - 2);
            const char* a1 = cA + (size_t)(t + 1) * kstep;
            const char* a2 = last ? nA : cA + (size_t)(t + 2) * kstep; const char* b2 = last ? nB : cB + (size_t)(t + 2) * kstep;
            const char* a3 = a2 + kstep; const char* b3 = b2 + kstep;
            if (last && has_next) S.a_ready(nxt);
            if constexpr (SP2) {
            PG8_LDB(B0, 0, 0); PG8_LDB(B1, 0, 1); PG8_SCHED; PG8_LDA(At, 0, 0); PG8_STAGE(PG8_SA(1, 1), a1 + hstep, voffA);
            PG8_WAIT_V(8); PG8_WAIT_L(0); PG8_BAR; PG8_MMA(0, 0, At, B0); PG8_MMA(0, 1, At, B1); PG8_BAR; PG8_SCHED;
            PG8_LDA(At, 0, 1); PG8_STAGE(PG8_SB(0, 0), b2, voffB); PG8_STAGE(PG8_SB(0, 1), b2 + hstep, voffB); PG8_STAGE(PG8_SA(0, 0), a2, voffA);
            PG8_WAIT_V(8); PG8_WAIT_L(0); PG8_BAR; PG8_MMA(1, 0, At, B0); PG8_MMA(1, 1, At, B1); PG8_BAR; PG8_SCHED;
            PG8_LDB(B0, 1, 0); PG8_LDB(B1, 1, 1); PG8_SCHED; PG8_LDA(At, 1, 0); PG8_STAGE(PG8_SA(0, 1), a2 + hstep, voffA);
            PG8_WAIT_V(8); PG8_WAIT_L(0); PG8_BAR; PG8_MMA(0, 0, At, B0); PG8_MMA(0, 1, At, B1); PG8_BAR; PG8_SCHED;
            PG8_LDA(At, 1, 1); PG8_STAGE(PG8_SB(1, 0), b3, voffB); PG8_STAGE(PG8_SB(1, 1), b3 + hstep, voffB); PG8_STAGE(PG8_SA(1, 0), a3, voffA);
            PG8_WAIT_V(8); PG8_WAIT_L(0); PG8_BAR; PG8_MMA(1, 0, At, B0); PG8_MMA(1, 1, At, B1); PG8_BAR; PG8_SCHED;
            } else {
            PG8_LDB(B0, 0, 0); PG8_SCHED; PG8_LDA(At, 0, 0); PG8_STAGE(PG8_SA(1, 1), a1 + hstep, voffA);
            PG8_WAIT_L(8); PG8_BAR; PG8_WAIT_L(0); PG8_MMA(0, 0, At, B0); PG8_BAR; PG8_SCHED;
            PG8_LDB(B1, 0, 1); PG8_STAGE(PG8_SB(0, 0), b2, voffB);
            PG8_BAR; PG8_WAIT_L(0); PG8_MMA(0, 1, At, B1); PG8_BAR;
            PG8_LDA(At, 0, 1); PG8_STAGE(PG8_SA(0, 0), a2, voffA);
            PG8_BAR; PG8_WAIT_L(0); PG8_MMA(1, 0, At, B0); PG8_BAR; PG8_SCHED;
            PG8_STAGE(PG8_SB(0, 1), b2 + hstep, voffB);
            PG8_WAIT_V(6); PG8_BAR; PG8_MMA(1, 1, At, B1); PG8_BAR;
            PG8_LDB(B0, 1, 0); PG8_SCHED; PG8_LDA(At, 1, 0); PG8_STAGE(PG8_SA(0, 1), a2 + hstep, voffA);
            PG8_WAIT_L(8); PG8_BAR; PG8_WAIT_L(0); PG8_MMA(0, 0, At, B0); PG8_BAR; PG8_SCHED;
            PG8_LDB(B1, 1, 1); PG8_STAGE(PG8_SB(1, 0), b3, voffB);
            PG8_BAR; PG8_WAIT_L(0); PG8_MMA(0, 1, At, B1); PG8_BAR;
            PG8_LDA(At, 1, 1); PG8_STAGE(PG8_SA(1, 0), a3, voffA);
            PG8_BAR; PG8_WAIT_L(0); PG8_MMA(1, 0, At, B0); PG8_BAR; PG8_SCHED;
            PG8_STAGE(PG8_SB(1, 1), b3 + hstep, voffB);
            PG8_WAIT_V(6); PG8_BAR; PG8_MMA(1, 1, At, B1); PG8_BAR;
            }
        }
        if constexpr (ALIGN_EPI) { if (wr == 0) PG8_BAR; }
        if constexpr (!Epi::AFTER_DRAIN) { E(acc, cur, wr, wc, fr, fq); S.done(cur); }
        if (!has_next) break;
#pragma unroll
        for (int a = 0; a < 2; ++a)
#pragma unroll
            for (int b = 0; b < 2; ++b)
#pragma unroll
                for (int m = 0; m < 4; ++m)
#pragma unroll
                    for (int n = 0; n < 2; ++n) acc[a][b][m][n] = (f32x4){0.f, 0.f, 0.f, 0.f};
        cur = nxt; cA = nA; cB = nB; ++ui;
        if constexpr (ALIGN_EPI) { if (wr == 1) PG8_BAR; }
    }
    PG8_WAIT_V(0);
    if constexpr (!ALIGN_EPI) { if (wr == 0) PG8_BAR; }
    PG8_BAR;
    if constexpr (Epi::AFTER_DRAIN) { E.fused(acc, cur, wr, wc, fr, fq, lds, wid, lane); S.done(cur); }
#undef PG8_SA
#undef PG8_SB
#undef PG8_STAGE
#undef PG8_LDA
#undef PG8_LDB
#undef PG8_MMA
#undef PG8_WAIT_V
#undef PG8_WAIT_L
#undef PG8_BAR
#undef PG8_SCHED
}

}
#define LAS __attribute__((address_space(3)))
#define XB_TMO      128
#define XB_XCNT(j)  (256  + 64 * (j))
#define XB_XSUB(j)  (1280 + 64 * (j))
#define XB_XGEN(j)  (2304 + 64 * (j))
#define XB_TOP      3328
#define XB_TOPGEN   3392
#define XCD_BAR_WORDS 3456
#define XB_SPIN_CAP (1u << 18)
typedef unsigned short bf16_t;
typedef short bf16x8 __attribute__((ext_vector_type(8)));
typedef float f32x4 __attribute__((ext_vector_type(4)));
typedef unsigned u32x4 __attribute__((ext_vector_type(4)));

constexpr int MP = 65536, MS = 512, MT = 66048;
constexpr int NTHR = 512, NWV = 8;
constexpr size_t al256(size_t x) { return (x + 255) & ~(size_t)255; }
constexpr size_t WS_ADA  = 0;
constexpr size_t WS_BT1  = al256(WS_ADA + 40 * 3072 * 4);
constexpr size_t WS_BT2  = al256(WS_BT1 + (size_t)4096 * 1024 * 2);
constexpr size_t WS_WG   = al256(WS_BT2 + (size_t)1024 * 1536 * 2);
constexpr size_t WS_AGG  = al256(WS_WG + 131072 * 2);
constexpr size_t WS_BAR  = al256(WS_AGG + (size_t)8 * 16 * 1024 * 2 * 4);
constexpr size_t WS_CNT  = al256(WS_BAR + XCD_BAR_WORDS * 4);
constexpr size_t WS_RSS  = al256(WS_CNT + (size_t)258 * 2 * 256);
constexpr size_t WS_HN   = al256(WS_RSS + (size_t)MT * 16 * 4);
constexpr size_t WS_LB   = WS_HN;
constexpr size_t WS_PROJ = al256(WS_HN + (size_t)MT * 1024 * 4);
constexpr size_t WS_YMIX = al256(WS_PROJ + (size_t)MT * 4096 * 2);
constexpr size_t WS_OM   = WS_HN;
constexpr size_t WS_END  = al256(WS_YMIX + (size_t)MT * 1536 * 2);
constexpr size_t O_Y = 0, O_CAP = (size_t)MT * 1024, O_LRP = O_CAP + 8 * 3 * 1024, O_CBP = O_LRP + 8 * 1024, O_CAS = O_CBP + 8 * 2 * 512,
                 O_LRS = O_CAS + 32 * 3 * 1024, O_CBS = O_LRS + 32 * 1024, O_END = O_CBS + 32 * 2 * 512;

struct Args {
    const float *xp, *xs, *cp, *cs, *cache_a, *state, *cache_b, *g_norm, *w_ada, *b_ada, *w_in, *w_conv_a, *b_conv_a, *w_rg, *b_rg, *w_ig, *b_ig, *lam, *w_conv_b, *w_out, *g_final;
    float* out; unsigned char* ws; int ph_lo, ph_hi;
};

__device__ __forceinline__ float bf_lo(unsigned u) { return __uint_as_float(u << 16); }
__device__ __forceinline__ float bf_hi(unsigned u) { return __uint_as_float(u & 0xffff0000u); }
__device__ __forceinline__ void unpack8(const u32x4 v, float* f) { f[0] = bf_lo(v.x); f[1] = bf_hi(v.x); f[2] = bf_lo(v.y); f[3] = bf_hi(v.y); f[4] = bf_lo(v.z); f[5] = bf_hi(v.z); f[6] = bf_lo(v.w); f[7] = bf_hi(v.w); }
__device__ __forceinline__ u32x4 pack8(const float* f) { u32x4 w; w.x = pg8::cvt_pk_bf16(f[0], f[1]); w.y = pg8::cvt_pk_bf16(f[2], f[3]); w.z = pg8::cvt_pk_bf16(f[4], f[5]); w.w = pg8::cvt_pk_bf16(f[6], f[7]); return w; }
__device__ __forceinline__ float sigmoidf_(float x) { return __builtin_amdgcn_rcpf(1.f + __builtin_amdgcn_exp2f(-1.44269504f * x)); }
template <int CTRL> __device__ __forceinline__ float dpp_keep(float old, float src) { return __int_as_float(__builtin_amdgcn_update_dpp(__float_as_int(old), __float_as_int(src), CTRL, 0xF, 0xF, false)); }


__device__ __forceinline__ unsigned xb_ld(unsigned* p)              { return __hip_atomic_load(p, __ATOMIC_RELAXED, __HIP_MEMORY_SCOPE_AGENT); }
__device__ __forceinline__ unsigned xb_add(unsigned* p, unsigned v) { return __hip_atomic_fetch_add(p, v, __ATOMIC_RELAXED, __HIP_MEMORY_SCOPE_AGENT); }
__device__ __forceinline__ unsigned xb_xcc_id() { return (unsigned)__builtin_amdgcn_s_getreg((3 << 11) | 20) & 0xFu; }
#define XB_SPIN(cond, bar) do { unsigned _sp = 0; while (cond) { __builtin_amdgcn_s_sleep(1); \
    if ((++_sp & 255u) == 0u) { if (xb_ld(&(bar)[XB_TMO])) break; if (_sp > XB_SPIN_CAP) { atomicAdd(&(bar)[XB_TMO], 1u); break; } } } } while (0)
struct XcdBarrier {
    unsigned* bar; unsigned x;
    volatile LAS unsigned* st;
};

__device__ __forceinline__ XcdBarrier xcd_barrier_post(unsigned* bar, volatile LAS unsigned* st) {
    XcdBarrier b; b.bar = bar; b.x = xb_xcc_id(); b.st = st;
    if (threadIdx.x == 0) (void)xb_add(&bar[XB_XCNT(b.x)], 1u);
    return b;
}
__device__ __forceinline__ void xcd_barrier_complete(unsigned* bar, unsigned x, unsigned& nloc, unsigned& nx) {
    const unsigned G = gridDim.x * gridDim.y * gridDim.z;
    unsigned sum, cnt, mine, sp = 0u;
    for (;;) {
        sum = 0u; cnt = 0u; mine = 0u;
#pragma unroll
        for (unsigned j = 0; j < 16; ++j) { const unsigned c = xb_ld(&bar[XB_XCNT(j)]); sum += c; cnt += (c > 0u) ? 1u : 0u; mine = (j == x) ? c : mine; }
        if (sum == G) break;
        __builtin_amdgcn_s_sleep(1);
        if ((++sp & 255u) == 0u) { if (xb_ld(&bar[XB_TMO])) break; if (sp > XB_SPIN_CAP) { atomicAdd(&bar[XB_TMO], 1u); break; } }
    }
    nloc = mine > 0u ? mine : 1u; nx = cnt > 0u ? cnt : 1u;
}

__device__ __forceinline__ void xcd_barrier(const XcdBarrier& b) {
    asm volatile("s_waitcnt vmcnt(0)" ::: "memory");
    __syncthreads();
    if (threadIdx.x == 0) {
        unsigned* bar = b.bar;
        __builtin_amdgcn_s_waitcnt(0);
        unsigned nloc = b.st[0], nx = b.st[1];
        if (nloc == 0u) { xcd_barrier_complete(bar, b.x, nloc, nx); b.st[0] = nloc; b.st[1] = nx; }
        const unsigned old = xb_add(&bar[XB_XSUB(b.x)], 1u);
        const unsigned gen = old / nloc;
        if (old + 1u == (gen + 1u) * nloc) {
            __builtin_amdgcn_fence(__ATOMIC_RELEASE, "agent");
            asm volatile("s_waitcnt vmcnt(0)" ::: "memory");
            const unsigned og = xb_add(&bar[XB_TOP], 1u);
            const unsigned tg = og / nx;
            if (og + 1u == (tg + 1u) * nx) xb_add(&bar[XB_TOPGEN], 1u);
            else XB_SPIN(xb_ld(&bar[XB_TOPGEN]) == tg, bar);
            __builtin_amdgcn_fence(__ATOMIC_ACQUIRE, "agent");
            xb_add(&bar[XB_XGEN(b.x)], 1u);
            asm volatile("s_waitcnt vmcnt(0)" ::: "memory");
        } else {
            XB_SPIN(xb_ld(&bar[XB_XGEN(b.x)]) == gen, bar);
            __builtin_amdgcn_fence(__ATOMIC_ACQUIRE, "agent");
            asm volatile("s_waitcnt vmcnt(0)" ::: "memory");
        }
    }
    __syncthreads();
}

#define XB_REC_WORDS 32

__device__ __forceinline__ void scan4(float& a0, float& a1, float& a2, float& a3, float& b0, float& b1, float& b2, float& b3, float h0, float h1, float h2, float h3) {
#define DPPM " row_mask:0xf bank_mask:0xf\n\t"
#define STEP(N) "v_fmac_f32_dpp %4, %4, %0 row_shr:" #N DPPM "v_fmac_f32_dpp %5, %5, %1 row_shr:" #N DPPM "v_fmac_f32_dpp %6, %6, %2 row_shr:" #N DPPM "v_fmac_f32_dpp %7, %7, %3 row_shr:" #N DPPM \
                "v_mul_f32_dpp %0, %0, %0 row_shr:" #N DPPM "v_mul_f32_dpp %1, %1, %1 row_shr:" #N DPPM "v_mul_f32_dpp %2, %2, %2 row_shr:" #N DPPM "v_mul_f32_dpp %3, %3, %3 row_shr:" #N DPPM
    asm volatile("s_nop 1\n\t"
        "v_fmac_f32_dpp %4, %8, %0 row_ror:1" DPPM "v_fmac_f32_dpp %5, %9, %1 row_ror:1" DPPM "v_fmac_f32_dpp %6, %10, %2 row_ror:1" DPPM "v_fmac_f32_dpp %7, %11, %3 row_ror:1" DPPM
        STEP(1) STEP(2) STEP(4) STEP(8)
        : "+v"(a0), "+v"(a1), "+v"(a2), "+v"(a3), "+v"(b0), "+v"(b1), "+v"(b2), "+v"(b3) : "v"(h0), "v"(h1), "v"(h2), "v"(h3));
#undef STEP
#undef DPPM
}

__device__ void p0_prologue(const Args& a, LAS unsigned char* lds) {
    const int tid = threadIdx.x, bx = blockIdx.x, G = gridDim.x;
    float* ada = (float*)(a.ws + WS_ADA);
    { unsigned* cz = (unsigned*)(a.ws + WS_CNT); for (int i = bx * NTHR + tid; i < 258 * 2 * 64; i += G * NTHR) cz[i] = 0u; }
    for (int it = bx; it < 192; it += G) {
        LAS float* sS = (LAS float*)lds; LAS float* red = (LAS float*)(lds + 40 * 256 * 4);
        const int n0 = it * 16, kq = tid >> 4, col = tid & 15;
        float acc[40];
#pragma unroll
        for (int b = 0; b < 40; ++b) acc[b] = 0.f;
        for (int kc = 0; kc < 4; ++kc) {
            __syncthreads();
            for (int i = tid; i < 40 * 256; i += NTHR) { const int b = i >> 8, kk = i & 255;
                const float cv = b < 8 ? a.cp[b * 1024 + kc * 256 + kk] : a.cs[(b - 8) * 1024 + kc * 256 + kk];
                sS[i] = cv * sigmoidf_(cv); }
            __syncthreads();
#pragma unroll
            for (int k8 = 0; k8 < 8; ++k8) { const float w = a.w_ada[(size_t)(kc * 256 + kq * 8 + k8) * 3072 + n0 + col];
#pragma unroll
                for (int b = 0; b < 40; ++b) acc[b] += sS[b * 256 + kq * 8 + k8] * w; }
        }
#pragma unroll
        for (int b = 0; b < 40; ++b) red[kq * 640 + col * 40 + b] = acc[b];
        __syncthreads();
        for (int o = tid; o < 640; o += NTHR) { float s = 0.f; for (int k = 0; k < 32; ++k) s += red[k * 640 + o];
            const int c = o / 40, b = o % 40; ada[b * 3072 + n0 + c] = s + a.b_ada[n0 + c]; }
        __syncthreads();
    }
    {
        LAS float* tile = (LAS float*)lds;
        for (int tl = bx; tl < 1024 + 384; tl += G) {
            const float* src; bf16_t* dst; int K, N, kt, nt;
            if (tl < 1024) { src = a.w_in; dst = (bf16_t*)(a.ws + WS_BT1); K = 1024; N = 4096; kt = tl >> 6; nt = tl & 63; }
            else { const int t2 = tl - 1024; src = a.w_out; dst = (bf16_t*)(a.ws + WS_BT2); K = 1536; N = 1024; kt = t2 >> 4; nt = t2 & 15; }
            __syncthreads();
#pragma unroll
            for (int ps = 0; ps < 2; ++ps) { const int rr = (tid >> 4) + ps * 32, c4 = (tid & 15) * 4;
                const f32x4 v = *(const f32x4*)(src + (size_t)(kt * 64 + rr) * N + nt * 64 + c4);
                tile[rr * 65 + c4 + 0] = v[0]; tile[rr * 65 + c4 + 1] = v[1]; tile[rr * 65 + c4 + 2] = v[2]; tile[rr * 65 + c4 + 3] = v[3]; }
            __syncthreads();
            { const int n = tid >> 3, k8 = tid & 7; float f[8];
#pragma unroll
              for (int e = 0; e < 8; ++e) f[e] = tile[(k8 * 8 + e) * 65 + n];
              *(u32x4*)(dst + (size_t)(nt * 64 + n) * K + kt * 64 + k8 * 8) = pack8(f); }
        }
        __syncthreads();
    }
    {
        bf16_t* wg = (bf16_t*)(a.ws + WS_WG);
        for (int i = bx * NTHR + tid; i < 131072; i += G * NTHR) {
            const int e = i & 7, lane = (i >> 3) & 63, ks = (i >> 9) & 1, nb = (i >> 10) & 3, g = (i >> 12) & 1, h = i >> 13;
            const int m = lane & 15, q = lane >> 4;
            const int k = ks * 32 + q * 8 + e, n = (nb >> 1) * 32 + (m >> 2) * 8 + (nb & 1) * 4 + (m & 3);
            const float v = (g ? a.w_ig : a.w_rg)[(size_t)h * 4096 + k * 64 + n];
            wg[i] = (bf16_t)(pg8::cvt_pk_bf16(-1.44269504f * v, 0.f) & 0xffffu);
        }
    }
}

__device__ void p1_norm(const Args& a) {
    const int lane = threadIdx.x & 63, gw = blockIdx.x * NWV + (threadIdx.x >> 6), nw = gridDim.x * NWV;
    const float* ada = (const float*)(a.ws + WS_ADA); bf16_t* hn = (bf16_t*)(a.ws + WS_HN);
    for (int rowa = gw; rowa < MT; rowa += 2 * nw) {
        const int nr = (rowa + nw < MT) ? 2 : 1;
        f32x4 v[2][4]; float ss[2] = {0.f, 0.f};
#pragma unroll
        for (int k = 0; k < 2; ++k) { const int row = (k < nr) ? rowa + k * nw : rowa;
            const float* xr = row < MP ? a.xp + (size_t)row * 1024 : a.xs + (size_t)(row - MP) * 1024;
#pragma unroll
            for (int i = 0; i < 4; ++i) v[k][i] = *(const f32x4*)(xr + (i * 64 + lane) * 4); }
#pragma unroll
        for (int k = 0; k < 2; ++k) {
#pragma unroll
            for (int i = 0; i < 4; ++i) ss[k] += v[k][i][0] * v[k][i][0] + v[k][i][1] * v[k][i][1] + v[k][i][2] * v[k][i][2] + v[k][i][3] * v[k][i][3];
#pragma unroll
            for (int o = 1; o < 64; o <<= 1) ss[k] += __shfl_xor(ss[k], o); }
#pragma unroll
        for (int k = 0; k < 2; ++k) { if (k < nr) { const int row = rowa + k * nw;
            const int b = row < MP ? (row >> 13) : 8 + ((row - MP) >> 4);
            const float rinv = rsqrtf(ss[k] * (1.f / 1024.f) + 1e-6f);
#pragma unroll
            for (int i = 0; i < 4; ++i) { const int c = (i * 64 + lane) * 4;
                const f32x4 g = *(const f32x4*)(a.g_norm + c), sc = *(const f32x4*)(ada + b * 3072 + 1024 + c), sh = *(const f32x4*)(ada + b * 3072 + c);
                const f32x4 o = (v[k][i] * rinv) * g * (sc + 1.f) + sh;
                uint2 w; w.x = pg8::cvt_pk_bf16(o[0], o[1]); w.y = pg8::cvt_pk_bf16(o[2], o[3]);
                *(uint2*)(hn + (size_t)row * 1024 + c) = w; } } }
    }
}

__device__ void p3_mixer_a1(const Args& a, LAS unsigned char* lds, const int gw, const int nw, const int ubeg, const int uend) {
    const int lane = threadIdx.x & 63, wv = threadIdx.x >> 6;
    const int r = lane & 15, q = lane >> 4;
    LAS float* tbl = (LAS float*)(lds + wv * 2048);
    const bf16_t* proj = (const bf16_t*)(a.ws + WS_PROJ); unsigned* LB = (unsigned*)(a.ws + WS_LB);
    float* agg = (float*)(a.ws + WS_AGG);
    for (int u = ubeg + gw; u < uend; u += nw) {
        int head, seq, chunk, L, tstart; size_t rowbase; bool sample, lastchunk;
        if (u < 2048) { head = u & 15; chunk = (u >> 4) & 15; seq = u >> 8; sample = false; rowbase = (size_t)seq * 8192; tstart = chunk * 512; L = 32; lastchunk = (chunk == 15); }
        else { const int v = u - 2048; head = v & 15; seq = v >> 4; chunk = 0; sample = true; rowbase = (size_t)MP + seq * 16; tstart = 0; L = 1; lastchunk = true; }
        __builtin_amdgcn_wave_barrier();
        { const int c = head * 64 + lane;
          tbl[0 * 64 + lane] = a.w_conv_a[0 * 1024 + c]; tbl[1 * 64 + lane] = a.w_conv_a[1 * 1024 + c]; tbl[2 * 64 + lane] = a.w_conv_a[2 * 1024 + c]; tbl[3 * 64 + lane] = a.w_conv_a[3 * 1024 + c];
          tbl[4 * 64 + lane] = a.b_conv_a[c]; tbl[5 * 64 + lane] = -1.44269504f * a.b_rg[c]; tbl[6 * 64 + lane] = -1.44269504f * a.b_ig[c];
          tbl[7 * 64 + lane] = -8.f * 1.44269504f * log1pf(__expf(-a.lam[c])); }
        __builtin_amdgcn_wave_barrier();
        bf16x8 wg[2][4][2];
        { const bf16x8* wgp = (const bf16x8*)(a.ws + WS_WG);
#pragma unroll
          for (int g = 0; g < 2; ++g)
#pragma unroll
            for (int nb = 0; nb < 4; ++nb)
#pragma unroll
              for (int ks = 0; ks < 2; ++ks) wg[g][nb][ks] = wgp[((((head * 2 + g) * 4 + nb) * 2 + ks) * 64) + lane]; }
        float hrun[16], prun[16];
#pragma unroll
        for (int i = 0; i < 16; ++i) { hrun[i] = 0.f; prun[i] = 1.f; }
        const int cb0 = head * 64 + q * 8;
        const int t0 = tstart + r * L;
        const bf16_t* prow = proj + (rowbase + t0) * 4096 + cb0;
        u32x4 W[3][2], Xn[2], Xn2[2];
#pragma unroll
        for (int kk = 0; kk < 3; ++kk)
#pragma unroll
            for (int ks = 0; ks < 2; ++ks) {
                const int trel = t0 - 3 + kk;
                u32x4 v = (u32x4){0u, 0u, 0u, 0u};
                if (trel >= 0) v = *(const u32x4*)(prow + (ptrdiff_t)(kk - 3) * 4096 + ks * 32);
                else if (sample) { const float* cpn = a.cache_a + ((size_t)seq * 3 + (3 + trel)) * 1024 + cb0 + ks * 32; float f[8];
#pragma unroll
                    for (int e = 0; e < 8; ++e) f[e] = cpn[e];
                    v = pack8(f); }
                W[kk][ks] = v; }
#pragma unroll
        for (int ks = 0; ks < 2; ++ks) { Xn[ks] = *(const u32x4*)(prow + ks * 32); Xn2[ks] = *(const u32x4*)(prow + (size_t)(L > 1 ? 1 : 0) * 4096 + ks * 32); }
        for (int blk = 0; blk < L; ++blk) {
            const size_t row = rowbase + t0 + blk;
            u32x4 Xc[2];
#pragma unroll
            for (int ks = 0; ks < 2; ++ks) { Xc[ks] = Xn[ks]; Xn[ks] = Xn2[ks]; }
            { const int nb2 = (blk + 2 < L) ? blk + 2 : L - 1;
#pragma unroll
              for (int ks = 0; ks < 2; ++ks) Xn2[ks] = *(const u32x4*)(prow + (size_t)nb2 * 4096 + ks * 32); }
            float xc[16]; bf16x8 af[2];
#pragma unroll
            for (int ks = 0; ks < 2; ++ks) {
                const int cl0 = ks * 32 + q * 8;
                float acc8[8];
                { const f32x4 b0 = *(const LAS f32x4*)(tbl + 4 * 64 + cl0), b1 = *(const LAS f32x4*)(tbl + 4 * 64 + cl0 + 4);
                  acc8[0] = b0[0]; acc8[1] = b0[1]; acc8[2] = b0[2]; acc8[3] = b0[3]; acc8[4] = b1[0]; acc8[5] = b1[1]; acc8[6] = b1[2]; acc8[7] = b1[3]; }
#pragma unroll
                for (int kk = 0; kk < 4; ++kk) {
                    float X[8]; unpack8(kk < 3 ? W[kk][ks] : Xc[ks], X);
                    const f32x4 w0 = *(const LAS f32x4*)(tbl + kk * 64 + cl0), w1 = *(const LAS f32x4*)(tbl + kk * 64 + cl0 + 4);
                    acc8[0] += w0[0] * X[0]; acc8[1] += w0[1] * X[1]; acc8[2] += w0[2] * X[2]; acc8[3] += w0[3] * X[3];
                    acc8[4] += w1[0] * X[4]; acc8[5] += w1[1] * X[5]; acc8[6] += w1[2] * X[6]; acc8[7] += w1[3] * X[7];
                }
#pragma unroll
                for (int e = 0; e < 8; ++e) xc[ks * 8 + e] = acc8[e];
                const u32x4 pk = pack8(acc8);
                af[ks] = __builtin_bit_cast(bf16x8, pk);
            }
            if (lastchunk && blk == L - 1 && r == 15) {
#pragma unroll
                for (int kk = 1; kk < 4; ++kk)
#pragma unroll
                    for (int ks = 0; ks < 2; ++ks) { float X[8]; unpack8(kk < 3 ? W[kk][ks] : Xc[ks], X);
                        float* o = a.out + (sample ? O_CAS : O_CAP) + ((size_t)seq * 3 + (kk - 1)) * 1024 + cb0 + ks * 32;
                        *(f32x4*)o = (f32x4){X[0], X[1], X[2], X[3]}; *(f32x4*)(o + 4) = (f32x4){X[4], X[5], X[6], X[7]}; }
            }
#pragma unroll
            for (int nb = 0; nb < 4; ++nb) {
                const int ks = nb >> 1, e0 = (nb & 1) * 4, cl0 = ks * 32 + q * 8 + e0, i0 = ks * 8 + e0;
                const f32x4 brg = *(const LAS f32x4*)(tbl + 5 * 64 + cl0), big = *(const LAS f32x4*)(tbl + 6 * 64 + cl0), nsp = *(const LAS f32x4*)(tbl + 7 * 64 + cl0);
                f32x4 R = __builtin_amdgcn_mfma_f32_16x16x32_bf16(wg[0][nb][0], af[0], brg, 0, 0, 0);
                R = __builtin_amdgcn_mfma_f32_16x16x32_bf16(wg[0][nb][1], af[1], R, 0, 0, 0);
                f32x4 I = __builtin_amdgcn_mfma_f32_16x16x32_bf16(wg[1][nb][0], af[0], big, 0, 0, 0);
                I = __builtin_amdgcn_mfma_f32_16x16x32_bf16(wg[1][nb][1], af[1], I, 0, 0, 0);
                u32x4 lbw;
#pragma unroll
                for (int j = 0; j < 4; ++j) {
                    const float rg = __builtin_amdgcn_rcpf(1.f + __builtin_amdgcn_exp2f(R[j]));
                    const float ig = __builtin_amdgcn_rcpf(1.f + __builtin_amdgcn_exp2f(I[j]));
                    const float la2 = nsp[j] * rg;
                    const float av = __builtin_amdgcn_exp2f(la2);
                    const float bb = __builtin_amdgcn_sqrtf(__builtin_fmaf(-av, av, 1.f)) * (ig * xc[i0 + j]);
                    lbw[j] = pg8::cvt_pk_bf16(la2, bb);
                    hrun[i0 + j] = __builtin_fmaf(av, hrun[i0 + j], bb);
                    prun[i0 + j] *= av;
                }
                *(u32x4*)(LB + row * 1024 + head * 64 + cl0) = lbw;
            }
#pragma unroll
            for (int ks = 0; ks < 2; ++ks) { W[0][ks] = W[1][ks]; W[1][ks] = W[2][ks]; W[2][ks] = Xc[ks]; }
        }
        if (!sample) {
#pragma unroll
            for (int g4 = 0; g4 < 4; ++g4) { const int i0 = g4 * 4;
                scan4(prun[i0], prun[i0 + 1], prun[i0 + 2], prun[i0 + 3], hrun[i0], hrun[i0 + 1], hrun[i0 + 2], hrun[i0 + 3], 0.f, 0.f, 0.f, 0.f); }
            if (r == 15) {
#pragma unroll
                for (int i = 0; i < 16; ++i) *(float2*)(agg + ((size_t)(seq * 16 + chunk) * 1024 + head * 64 + (i >> 3) * 32 + q * 8 + (i & 7)) * 2) = make_float2(prun[i], hrun[i]);
            }
        }
    }
}

struct A2Regs { u32x4 lb[4]; u32x4 g[2]; };
__device__ __forceinline__ void a2_load(A2Regs& R, const unsigned* LB, const bf16_t* proj, size_t row, int cb) {
#pragma unroll
    for (int ks = 0; ks < 2; ++ks) { const unsigned* lp = LB + row * 1024 + cb + ks * 32; R.lb[ks * 2] = *(const u32x4*)lp; R.lb[ks * 2 + 1] = *(const u32x4*)(lp + 4);
        R.g[ks] = *(const u32x4*)(proj + row * 4096 + 1024 + cb + ks * 32); }
}
__device__ __forceinline__ void a2_block(const A2Regs& R, float (&hprev)[16], bf16_t* ymix, size_t row, int cb, int r) {
#pragma unroll
    for (int ks = 0; ks < 2; ++ks) {
        float G[8]; unpack8(R.g[ks], G);
        float y[8];
#pragma unroll
        for (int hh = 0; hh < 2; ++hh) {
            const u32x4 w = R.lb[ks * 2 + hh]; const int i0 = ks * 8 + hh * 4;
            float av[4], bb[4], hm[4];
#pragma unroll
            for (int j = 0; j < 4; ++j) { av[j] = __builtin_amdgcn_exp2f(bf_lo(w[j])); bb[j] = bf_hi(w[j]); hm[j] = (r == 15) ? hprev[i0 + j] : 0.f; }
            scan4(av[0], av[1], av[2], av[3], bb[0], bb[1], bb[2], bb[3], hm[0], hm[1], hm[2], hm[3]);
#pragma unroll
            for (int j = 0; j < 4; ++j) { hprev[i0 + j] = bb[j]; const float g = G[hh * 4 + j]; y[hh * 4 + j] = bb[j] * (g * sigmoidf_(g)); }
        }
        *(u32x4*)(ymix + row * 1536 + cb + ks * 32) = pack8(y);
    }
}
__device__ void p4_mixer_a2(const Args& a) {
    const int lane = threadIdx.x & 63, wv = threadIdx.x >> 6, gw = blockIdx.x * NWV + wv, nw = gridDim.x * NWV;
    const int r = lane & 15, q = lane >> 4;
    const bf16_t* proj = (const bf16_t*)(a.ws + WS_PROJ); bf16_t* ymix = (bf16_t*)(a.ws + WS_YMIX); const unsigned* LB = (const unsigned*)(a.ws + WS_LB);
    const float* agg = (const float*)(a.ws + WS_AGG);
    for (int u = gw; u < 2560; u += nw) {
        int head, seq, chunk, nblk, tstart; size_t rowbase; bool sample, lastchunk;
        if (u < 2048) { head = u & 15; chunk = (u >> 4) & 15; seq = u >> 8; sample = false; rowbase = (size_t)seq * 8192; tstart = chunk * 512; nblk = 32; lastchunk = (chunk == 15); }
        else { const int v = u - 2048; head = v & 15; seq = v >> 4; chunk = 0; sample = true; rowbase = (size_t)MP + seq * 16; tstart = 0; nblk = 1; lastchunk = true; }
        const int cb = head * 64 + q * 8;
        float hprev[16];
#pragma unroll
        for (int i = 0; i < 16; ++i) hprev[i] = 0.f;
        if (sample) {
#pragma unroll
            for (int i = 0; i < 16; ++i) hprev[i] = a.state[(size_t)seq * 1024 + cb + (i >> 3) * 32 + (i & 7)];
        } else {
            for (int jj = 0; jj < chunk; ++jj) {
#pragma unroll
                for (int i = 0; i < 16; ++i) { const float2 ph = *(const float2*)(agg + ((size_t)(seq * 16 + jj) * 1024 + cb + (i >> 3) * 32 + (i & 7)) * 2);
                    hprev[i] = ph.x * hprev[i] + ph.y; }
            }
        }
        const size_t row0 = rowbase + tstart + r;
        if (nblk == 1) { A2Regs c0; a2_load(c0, LB, proj, row0, cb); a2_block(c0, hprev, ymix, row0, cb, r); }
        else {
            A2Regs c0, c1, n0, n1;
            a2_load(c0, LB, proj, row0, cb); a2_load(c1, LB, proj, row0 + 16, cb);
            for (int blk = 0; blk < nblk; blk += 2) {
                const size_t row = row0 + (size_t)blk * 16;
                const size_t rown = (blk + 2 < nblk) ? row + 32 : row;
                a2_load(n0, LB, proj, rown, cb); a2_load(n1, LB, proj, rown + 16, cb);
                a2_block(c0, hprev, ymix, row, cb, r); a2_block(c1, hprev, ymix, row + 16, cb, r);
                c0 = n0; c1 = n1;
            }
        }
        if (lastchunk && r == 15) {
#pragma unroll
            for (int ks = 0; ks < 2; ++ks) { float* o = a.out + (sample ? O_LRS : O_LRP) + (size_t)seq * 1024 + cb + ks * 32;
                *(f32x4*)o = (f32x4){hprev[ks * 8 + 0], hprev[ks * 8 + 1], hprev[ks * 8 + 2], hprev[ks * 8 + 3]};
                *(f32x4*)(o + 4) = (f32x4){hprev[ks * 8 + 4], hprev[ks * 8 + 5], hprev[ks * 8 + 6], hprev[ks * 8 + 7]}; }
        }
    }
}

__device__ void p3_mixer_b(const Args& a, const int tix, const int tn) {
    const bf16_t* proj = (const bf16_t*)(a.ws + WS_PROJ); bf16_t* ymix = (bf16_t*)(a.ws + WS_YMIX);
    for (int it = tix; it < (MP / 16) * 64; it += tn) {
        const int rb = it >> 6, cg = it & 63, c0 = cg * 8;
        const int seq = rb >> 9, t0 = (rb & 511) * 16;
        const size_t rowbase = (size_t)seq * 8192;
        float w[3][8];
#pragma unroll
        for (int k = 0; k < 3; ++k) { const f32x4 w0 = *(const f32x4*)(a.w_conv_b + k * 512 + c0), w1 = *(const f32x4*)(a.w_conv_b + k * 512 + c0 + 4);
            w[k][0] = w0[0]; w[k][1] = w0[1]; w[k][2] = w0[2]; w[k][3] = w0[3]; w[k][4] = w1[0]; w[k][5] = w1[1]; w[k][6] = w1[2]; w[k][7] = w1[3]; }
        float vm2[8], vm1[8];
        if (t0 > 0) {
            float xa[8], ca[8];
            unpack8(*(const u32x4*)(proj + (rowbase + t0 - 2) * 4096 + 2048 + c0), xa); unpack8(*(const u32x4*)(proj + (rowbase + t0 - 2) * 4096 + 3072 + c0), ca);
#pragma unroll
            for (int e = 0; e < 8; ++e) vm2[e] = xa[e] * ca[e];
            unpack8(*(const u32x4*)(proj + (rowbase + t0 - 1) * 4096 + 2048 + c0), xa); unpack8(*(const u32x4*)(proj + (rowbase + t0 - 1) * 4096 + 3072 + c0), ca);
#pragma unroll
            for (int e = 0; e < 8; ++e) vm1[e] = xa[e] * ca[e];
        } else {
#pragma unroll
            for (int e = 0; e < 8; ++e) { vm2[e] = 0.f; vm1[e] = 0.f; }
        }
        for (int tt = 0; tt < 16; ++tt) {
            const size_t row = rowbase + t0 + tt;
            float xb[8], cgt[8], bg[8], gb[8];
            unpack8(*(const u32x4*)(proj + row * 4096 + 2048 + c0), xb); unpack8(*(const u32x4*)(proj + row * 4096 + 2560 + c0), bg);
            unpack8(*(const u32x4*)(proj + row * 4096 + 3072 + c0), cgt); unpack8(*(const u32x4*)(proj + row * 4096 + 3584 + c0), gb);
            float y[8];
#pragma unroll
            for (int e = 0; e < 8; ++e) { const float v = cgt[e] * xb[e]; const float uu = w[0][e] * vm2[e] + w[1][e] * vm1[e] + w[2][e] * v;
                y[e] = bg[e] * uu * (gb[e] * sigmoidf_(gb[e])); vm2[e] = vm1[e]; vm1[e] = v; }
            *(u32x4*)(ymix + row * 1536 + 1024 + c0) = pack8(y);
        }
        if ((rb & 511) == 511) { float* o = a.out + O_CBP + (size_t)seq * 2 * 512 + c0;
#pragma unroll
            for (int e = 0; e < 8; ++e) { o[e] = vm2[e]; o[512 + e] = vm1[e]; } }
    }
    for (int it = tix; it < MS * 64; it += tn) {
        const int cg = it & 63, c0 = cg * 8, t = (it >> 6) & 15, seq = it >> 10;
        const size_t row = (size_t)MP + seq * 16 + t;
        float v[3][8];
#pragma unroll
        for (int k = 0; k < 3; ++k) { const int tr = t - 2 + k;
            if (tr >= 0) { float xa[8], ca[8]; unpack8(*(const u32x4*)(proj + (row - 2 + k) * 4096 + 2048 + c0), xa); unpack8(*(const u32x4*)(proj + (row - 2 + k) * 4096 + 3072 + c0), ca);
#pragma unroll
                for (int e = 0; e < 8; ++e) v[k][e] = xa[e] * ca[e]; }
            else {
#pragma unroll
                for (int e = 0; e < 8; ++e) v[k][e] = a.cache_b[((size_t)seq * 2 + (2 + tr)) * 512 + c0 + e]; } }
        float bg[8], gb[8], y[8];
        unpack8(*(const u32x4*)(proj + row * 4096 + 2560 + c0), bg); unpack8(*(const u32x4*)(proj + row * 4096 + 3584 + c0), gb);
#pragma unroll
        for (int e = 0; e < 8; ++e) { const float uu = a.w_conv_b[c0 + e] * v[0][e] + a.w_conv_b[512 + c0 + e] * v[1][e] + a.w_conv_b[1024 + c0 + e] * v[2][e];
            y[e] = bg[e] * uu * (gb[e] * sigmoidf_(gb[e])); }
        *(u32x4*)(ymix + row * 1536 + 1024 + c0) = pack8(y);
        if (t == 15) { float* o = a.out + O_CBS + (size_t)seq * 2 * 512 + c0;
#pragma unroll
            for (int e = 0; e < 8; ++e) { o[e] = v[1][e]; o[512 + e] = v[2][e]; } }
    }
}

__device__ void p5_final(const Args& a) {
    const int lane = threadIdx.x & 63, gw = blockIdx.x * NWV + (threadIdx.x >> 6), nw = gridDim.x * NWV;
    const float* rss = (const float*)(a.ws + WS_RSS);
    for (int row = gw; row < MT; row += nw) {
        float* yr = a.out + (size_t)row * 1024;
        float ss = lane < 16 ? rss[(size_t)row * 16 + lane] : 0.f;
#pragma unroll
        for (int o = 1; o < 16; o <<= 1) ss += __shfl_xor(ss, o);
        ss = __shfl(ss, 0);
        const float rinv = rsqrtf(ss * (1.f / 1024.f) + 1e-6f);
#pragma unroll
        for (int i = 0; i < 4; ++i) { const int c = (i * 64 + lane) * 4;
            const f32x4 v = *(const f32x4*)(yr + c), g = *(const f32x4*)(a.g_final + c);
            *(f32x4*)(yr + c) = (v * rinv) * g; }
    }
}


__device__ void p6_final(const Args& a) {
    const int lane = threadIdx.x & 63, gw = blockIdx.x * NWV + (threadIdx.x >> 6), nw = gridDim.x * NWV;
    const float* ada = (const float*)(a.ws + WS_ADA); const bf16_t* om = (const bf16_t*)(a.ws + WS_OM);
    for (int rowa = gw; rowa < MT; rowa += 2 * nw) {
        const int nr = (rowa + nw < MT) ? 2 : 1;
        f32x4 v[2][4]; uint2 w[2][4];
#pragma unroll
        for (int k = 0; k < 2; ++k) { const int row = (k < nr) ? rowa + k * nw : rowa;
            const float* xr = row < MP ? a.xp + (size_t)row * 1024 : a.xs + (size_t)(row - MP) * 1024;
#pragma unroll
            for (int i = 0; i < 4; ++i) { v[k][i] = *(const f32x4*)(xr + (i * 64 + lane) * 4); w[k][i] = *(const uint2*)(om + (size_t)row * 1024 + (i * 64 + lane) * 4); } }
        float ss[2] = {0.f, 0.f};
#pragma unroll
        for (int k = 0; k < 2; ++k) { const int row = (k < nr) ? rowa + k * nw : rowa;
            const int b = row < MP ? (row >> 13) : 8 + ((row - MP) >> 4);
#pragma unroll
            for (int i = 0; i < 4; ++i) { const f32x4 g = *(const f32x4*)(ada + (size_t)b * 3072 + 2048 + (i * 64 + lane) * 4);
                const f32x4 o = (f32x4){bf_lo(w[k][i].x), bf_hi(w[k][i].x), bf_lo(w[k][i].y), bf_hi(w[k][i].y)};
                v[k][i] = v[k][i] + g * o;
                ss[k] += v[k][i][0] * v[k][i][0] + v[k][i][1] * v[k][i][1] + v[k][i][2] * v[k][i][2] + v[k][i][3] * v[k][i][3]; }
#pragma unroll
            for (int o = 1; o < 64; o <<= 1) ss[k] += __shfl_xor(ss[k], o); }
#pragma unroll
        for (int k = 0; k < 2; ++k) { if (k < nr) { const int row = rowa + k * nw;
            const float rinv = rsqrtf(ss[k] * (1.f / 1024.f) + 1e-6f);
            float* yr = a.out + (size_t)row * 1024;
#pragma unroll
            for (int i = 0; i < 4; ++i) { const int c = (i * 64 + lane) * 4; const f32x4 g = *(const f32x4*)(a.g_final + c);
                *(f32x4*)(yr + c) = (v[k][i] * rinv) * g; } } }
    }
}

__global__ void __launch_bounds__(NTHR, 2) mega_fwd(Args a) {
    extern __shared__ __attribute__((aligned(16))) unsigned char lds_raw[];
    LAS unsigned char* lds = (LAS unsigned char*)lds_raw;
    cg::grid_group grid = cg::this_grid();
    const int lo = a.ph_lo, hi = a.ph_hi;
    if (hi > 1000) grid.sync();
    if (threadIdx.x < 4) ((LAS unsigned*)(lds + pg8::STAGE_BYTES))[threadIdx.x] = 0u;
    __syncthreads();
    XcdBarrier bar = xcd_barrier_post((unsigned*)(a.ws + WS_BAR), (volatile LAS unsigned*)(lds + pg8::STAGE_BYTES));
#define IN(k) (lo <= (k) && (k) < hi)
#define SEAM(k) do { if (IN(k) && IN((k) + 1)) xcd_barrier(bar); } while (0)
    if (IN(0)) p0_prologue(a, lds);
    SEAM(0);
    if (IN(1)) p1_norm(a);
    SEAM(1);
    if (IN(2)) { pg8::Gemm g{(const bf16_t*)(a.ws + WS_HN), (const bf16_t*)(a.ws + WS_BT1), MT, 4096, 1024}; pg8::StaticOrder S; S.init(MT, 4096, (int)gridDim.x, (int)blockIdx.x);
        pg8::EpiBf16 E{(bf16_t*)(a.ws + WS_PROJ), 4096};
        pg8::gemm_phase_sp2<pg8::EpiBf16, pg8::StaticOrder, true, true>(lds, g, S, E); }
    SEAM(2);
    if (IN(3)) {
        if (threadIdx.x < 256) p3_mixer_a1(a, lds, (int)blockIdx.x * 4 + (int)(threadIdx.x >> 6), (int)gridDim.x * 4, 0, 2048);
        else { p3_mixer_b(a, (int)blockIdx.x * 256 + (int)threadIdx.x - 256, (int)gridDim.x * 256);
               p3_mixer_a1(a, lds, (int)blockIdx.x * 4 + (int)(threadIdx.x >> 6) - 4, (int)gridDim.x * 4, 2048, 2560); } }
    SEAM(3);
    if (IN(4)) p4_mixer_a2(a);
    SEAM(4);
    if (IN(5)) { pg8::Gemm g{(const bf16_t*)(a.ws + WS_YMIX), (const bf16_t*)(a.ws + WS_BT2), MT, 1024, 1536}; pg8::StaticOrder S; S.init(MT, 1024, (int)gridDim.x, (int)blockIdx.x);
        pg8::EpiBf16 E{(bf16_t*)(a.ws + WS_OM), 1024};
        pg8::gemm_phase_sp2<pg8::EpiBf16, pg8::StaticOrder, true, true>(lds, g, S, E); }
    SEAM(5);
    if (IN(6)) p6_final(a);
#undef IN
#undef SEAM
}

#ifndef N_LAUNCHES
#define N_LAUNCHES 1
#endif
constexpr int NPH = 7, LDS_BYTES = pg8::STAGE_BYTES + 16;

extern "C" void kernel_launch(void* const* d_in, const int* in_sizes, int n_in, void* d_out, int out_size, void* d_ws, size_t ws_size, hipStream_t stream) {
    static int grid = 0;
    if (grid == 0) {
        if (n_in != 21 || (size_t)out_size != O_END || ws_size < WS_END) { fprintf(stderr, "kernel_launch: unexpected shapes (n_in %d out %d ws %zu need %zu)\n", n_in, out_size, ws_size, (size_t)WS_END); grid = -1; return; }
        int dev = 0, cus = 0, per_cu = 0;
        hipGetDevice(&dev); hipDeviceGetAttribute(&cus, hipDeviceAttributeMultiprocessorCount, dev);
        if (hipFuncSetAttribute((const void*)mega_fwd, hipFuncAttributeMaxDynamicSharedMemorySize, LDS_BYTES) != hipSuccess) { fprintf(stderr, "kernel_launch: hipFuncSetAttribute failed\n"); grid = -1; return; }
        if (hipOccupancyMaxActiveBlocksPerMultiprocessor(&per_cu, (const void*)mega_fwd, NTHR, LDS_BYTES) != hipSuccess || per_cu < 1) { fprintf(stderr, "kernel_launch: occupancy query says %d\n", per_cu); per_cu = 1; }
        (void)hipGetLastError();
        grid = cus * 1;
    }
    if (grid < 0) return;
    if (hipMemsetAsync((char*)d_ws + WS_BAR, 0, XCD_BAR_WORDS * 4, stream) != hipSuccess) { fprintf(stderr, "kernel_launch: memset failed\n"); return; }
    Args a{};
    const float** ip = (const float**)&a;
    for (int i = 0; i < 21; ++i) ip[i] = (const float*)d_in[i];
    a.out = (float*)d_out; a.ws = (unsigned char*)d_ws;
#if N_LAUNCHES == 1
    a.ph_lo = 0; a.ph_hi = NPH;
    void* args[] = {&a};
    hipError_t e = hipLaunchCooperativeKernel((const void*)mega_fwd, dim3(grid), dim3(NTHR), args, LDS_BYTES, stream);
    if (e != hipSuccess) fprintf(stderr, "cooperative launch failed: %s (grid %d)\n", hipGetErrorString(e), grid);
#else
    for (int ph = 0; ph < NPH; ++ph) { a.ph_lo = ph; a.ph_hi = ph + 1; hipLaunchKernelGGL(mega_fwd, dim3(grid), dim3(NTHR), LDS_BYTES, stream, a); }
#endif
}
```
